# Optimizing an MI355X kernel written in HIP

```python
import jax, jax.numpy as jnp
from jax import lax
import numpy as np

D_MODEL = 1024
BATCH = 4
SEQ = 4096
DEPTH = 1

HEAD_DIM = 64
FOX_HEADS = 8
MOBA_HEADS = 8
FOX_WIDTH = FOX_HEADS * HEAD_DIM
MOBA_WIDTH = MOBA_HEADS * HEAD_DIM
ROPE_DIM = HEAD_DIM // 4
ROPE_THETA = 500000.0
FOX_Q_BLOCK = 128
FOX_FORGET_BIAS = 2.0
MOBA_BLOCK = 256
MOBA_TOPK = 3
MOBA_Q_CHUNK = 32
RMS_EPS = 1e-6
IN_SPLITS = (FOX_WIDTH, FOX_WIDTH, FOX_WIDTH, FOX_WIDTH,
             MOBA_WIDTH, MOBA_WIDTH, MOBA_WIDTH, MOBA_WIDTH,
             D_MODEL, D_MODEL, FOX_HEADS)
IN_WIDTH = 4 * FOX_WIDTH + 4 * MOBA_WIDTH + 2 * D_MODEL + FOX_HEADS

kernel_name = "fox_moba_gated_hybrid"


def rms_norm(x, g):
    xf = x.astype(jnp.float32)
    y = xf * lax.rsqrt(jnp.mean(xf * xf, axis=-1, keepdims=True) + RMS_EPS)
    return (y * g.astype(jnp.float32)).astype(x.dtype)


def split_cols(t, sizes):
    outs, off = [], 0
    for size in sizes:
        outs.append(t[..., off:off + size])
        off += size
    return outs


def to_heads(t, n_heads):
    b, s, _ = t.shape
    return t.reshape(b, s, n_heads, HEAD_DIM).transpose(0, 2, 1, 3)


def from_heads(t):
    b, h, s, d = t.shape
    return t.transpose(0, 2, 1, 3).reshape(b, s, h * d)


def partial_rope(t, positions):
    half = ROPE_DIM // 2
    inv_freq = ROPE_THETA ** (-jnp.arange(0, half, dtype=jnp.float32) * 2.0 / ROPE_DIM)
    ang = positions.astype(jnp.float32)[:, None] * inv_freq[None, :]
    cos, sin = jnp.cos(ang), jnp.sin(ang)
    tf = t.astype(jnp.float32)
    x1, x2, rest = tf[..., :half], tf[..., half:ROPE_DIM], tf[..., ROPE_DIM:]
    rot = jnp.concatenate([x1 * cos - x2 * sin, x2 * cos + x1 * sin, rest], axis=-1)
    return rot.astype(t.dtype)


def fox_attention(q, k, v, log_f):
    b, h, s, d = q.shape
    scale = d ** -0.5
    c = jnp.cumsum(log_f, axis=-1)
    kpos = jnp.arange(s)
    n_blocks = s // FOX_Q_BLOCK

    def one_block(i):
        start = i * FOX_Q_BLOCK
        qb = lax.dynamic_slice_in_dim(q, start, FOX_Q_BLOCK, axis=2)
        cb = lax.dynamic_slice_in_dim(c, start, FOX_Q_BLOCK, axis=2)
        logits = jnp.einsum("bhqd,bhkd->bhqk", qb, k).astype(jnp.float32) * scale
        logits = logits + cb[..., :, None] - c[..., None, :]
        qpos = start + jnp.arange(FOX_Q_BLOCK)
        logits = jnp.where(kpos[None, :] <= qpos[:, None], logits, -jnp.inf)
        p = jax.nn.softmax(logits, axis=-1)
        return jnp.einsum("bhqk,bhkd->bhqd", p.astype(v.dtype), v)

    out = lax.map(one_block, jnp.arange(n_blocks))
    return out.transpose(1, 2, 0, 3, 4).reshape(b, h, s, d)


def moba_attention(q, k, v):
    b, h, s, d = q.shape
    scale = d ** -0.5
    n_kb = -(-s // MOBA_BLOCK)
    s_pad = n_kb * MOBA_BLOCK
    pad = ((0, 0), (0, 0), (0, s_pad - s), (0, 0))
    q, k, v = jnp.pad(q, pad), jnp.pad(k, pad), jnp.pad(v, pad)
    kb = k.reshape(b, h, n_kb, MOBA_BLOCK, d)
    vb = v.reshape(b, h, n_kb, MOBA_BLOCK, d)
    k_mean = jnp.mean(kb.astype(jnp.float32), axis=3)
    n_sel = min(MOBA_TOPK, n_kb)
    blk_ids = jnp.arange(n_kb)
    b_ix = jnp.arange(b)[:, None, None, None]
    h_ix = jnp.arange(h)[None, :, None, None]
    n_chunks = s_pad // MOBA_Q_CHUNK

    def one_chunk(ci):
        start = ci * MOBA_Q_CHUNK
        own = start // MOBA_BLOCK
        qc = lax.dynamic_slice_in_dim(q, start, MOBA_Q_CHUNK, axis=2)
        gate = jnp.einsum("bhtd,bhnd->bhtn", qc.astype(jnp.float32), k_mean)
        gate = jnp.where(blk_ids < own, gate, -jnp.inf)
        _, sel = lax.top_k(gate, n_sel)
        valid = sel < own
        k_sel = kb[b_ix, h_ix, sel]
        v_sel = vb[b_ix, h_ix, sel]
        s_sel = jnp.einsum("bhtd,bhtnld->bhtnl", qc, k_sel).astype(jnp.float32) * scale
        s_sel = jnp.where(valid[..., None], s_sel, -jnp.inf)
        s_sel = s_sel.reshape(b, h, MOBA_Q_CHUNK, n_sel * MOBA_BLOCK)
        k_own = lax.dynamic_index_in_dim(kb, own, axis=2, keepdims=False)
        v_own = lax.dynamic_index_in_dim(vb, own, axis=2, keepdims=False)
        s_own = jnp.einsum("bhtd,bhld->bhtl", qc, k_own).astype(jnp.float32) * scale
        qpos = start + jnp.arange(MOBA_Q_CHUNK)
        kpos = own * MOBA_BLOCK + jnp.arange(MOBA_BLOCK)
        s_own = jnp.where(kpos[None, :] <= qpos[:, None], s_own, -jnp.inf)
        p = jax.nn.softmax(jnp.concatenate([s_sel, s_own], axis=-1), axis=-1).astype(v.dtype)
        p_sel = p[..., :n_sel * MOBA_BLOCK].reshape(b, h, MOBA_Q_CHUNK, n_sel, MOBA_BLOCK)
        p_own = p[..., n_sel * MOBA_BLOCK:]
        return (jnp.einsum("bhtnl,bhtnld->bhtd", p_sel, v_sel)
                + jnp.einsum("bhtl,bhld->bhtd", p_own, v_own))

    out = lax.map(one_chunk, jnp.arange(n_chunks))
    out = out.transpose(1, 2, 0, 3, 4).reshape(b, h, s_pad, d)
    return out[:, :, :s]


def setup_inputs(seed: int = 0) -> dict:
    key = jax.random.key(seed)
    ks = jax.random.split(key, 12)
    f32 = jnp.float32
    x = jax.random.normal(ks[0], (BATCH, SEQ, D_MODEL), f32)
    norm_g = 1.0 + 0.02 * jax.random.normal(ks[1], (DEPTH, D_MODEL), f32)
    w_in = jax.random.normal(ks[2], (DEPTH, D_MODEL, IN_WIDTH), f32) * D_MODEL ** -0.5
    b_f = FOX_FORGET_BIAS + 0.1 * jax.random.normal(ks[3], (DEPTH, FOX_HEADS), f32)
    b_gate = 0.02 * jax.random.normal(ks[4], (DEPTH, 2, D_MODEL), f32)
    fox_q_g = 1.0 + 0.02 * jax.random.normal(ks[5], (DEPTH, HEAD_DIM), f32)
    fox_k_g = 1.0 + 0.02 * jax.random.normal(ks[6], (DEPTH, HEAD_DIM), f32)
    moba_q_g = 1.0 + 0.02 * jax.random.normal(ks[7], (DEPTH, HEAD_DIM), f32)
    moba_k_g = 1.0 + 0.02 * jax.random.normal(ks[8], (DEPTH, HEAD_DIM), f32)
    w_fox = jax.random.normal(ks[9], (DEPTH, FOX_WIDTH, D_MODEL), f32) * FOX_WIDTH ** -0.5
    w_moba = jax.random.normal(ks[10], (DEPTH, MOBA_WIDTH, D_MODEL), f32) * MOBA_WIDTH ** -0.5
    w_out = jax.random.normal(ks[11], (DEPTH, D_MODEL, D_MODEL), f32) * D_MODEL ** -0.5
    return {"x": x, "norm_g": norm_g, "w_in": w_in, "b_f": b_f, "b_gate": b_gate,
            "fox_q_g": fox_q_g, "fox_k_g": fox_k_g, "moba_q_g": moba_q_g,
            "moba_k_g": moba_k_g, "w_fox": w_fox, "w_moba": w_moba, "w_out": w_out}


def reference(x, norm_g, w_in, b_f, b_gate, fox_q_g, fox_k_g, moba_q_g, moba_k_g,
              w_fox, w_moba, w_out):
    seq = x.shape[1]
    positions = jnp.arange(seq, dtype=jnp.int32)
    for layer in range(DEPTH):
        h = rms_norm(x, norm_g[layer])
        proj = h @ w_in[layer]
        fq, fk, fv, fz, mq, mk, mv, mz, ga, gb, fl = split_cols(proj, IN_SPLITS)
        q = rms_norm(to_heads(fq, FOX_HEADS), fox_q_g[layer])
        k = rms_norm(to_heads(fk, FOX_HEADS), fox_k_g[layer])
        v = to_heads(fv, FOX_HEADS)
        log_f = jax.nn.log_sigmoid((fl + b_f[layer]).astype(jnp.float32)).transpose(0, 2, 1)
        y_fox = from_heads(fox_attention(q, k, v, log_f)) * jax.nn.silu(fz)
        q = partial_rope(rms_norm(to_heads(mq, MOBA_HEADS), moba_q_g[layer]), positions)
        k = partial_rope(rms_norm(to_heads(mk, MOBA_HEADS), moba_k_g[layer]), positions)
        v = to_heads(mv, MOBA_HEADS)
        y_moba = from_heads(moba_attention(q, k, v)) * jax.nn.silu(mz)
        merged = (jax.nn.sigmoid(ga + b_gate[layer, 0]) * (y_fox @ w_fox[layer])
                  + jax.nn.sigmoid(gb + b_gate[layer, 1]) * (y_moba @ w_moba[layer]))
        x = x + merged @ w_out[layer]
    return x
```

```cpp
#include <hip/hip_runtime.h>
#include <hip/hip_cooperative_groups.h>
#include <cstdio>
#include <cstdint>

#define LAS __attribute__((address_space(3)))
typedef _Float16 h16;
typedef _Float16 f16x8 __attribute__((ext_vector_type(8)));
typedef _Float16 f16x2 __attribute__((ext_vector_type(2)));
typedef float f32x2 __attribute__((ext_vector_type(2)));
typedef float f32x4 __attribute__((ext_vector_type(4)));
typedef float f32x16 __attribute__((ext_vector_type(16)));
typedef unsigned u32x4 __attribute__((ext_vector_type(4)));
typedef unsigned u32x2 __attribute__((ext_vector_type(2)));
typedef short s16x4 __attribute__((ext_vector_type(4)));

constexpr int BATCH = 4, SEQ = 4096, DM = 1024, NH = 8, HD = 64, M = BATCH * SEQ;
constexpr int IN_W = 6152, IN_WG = 6144;
constexpr float RMS_EPS = 1e-6f;
constexpr float LOG2E = 1.4426950408889634f;
constexpr float QSCALE = 0.125f * 1.4426950408889634f;
constexpr int NWAVES = 8;

constexpr size_t MiB = 1u << 20;
constexpr size_t WS_CTL = 0, CTL_ZERO_BYTES = 64 * 1024;
constexpr size_t WS_WIN = 2 * MiB;
constexpr size_t WS_WCAT = 14 * MiB;
constexpr size_t WS_WOUT = 16 * MiB;
constexpr size_t WS_ROPE = 18 * MiB;
constexpr size_t WS_LOGF = 19 * MiB;
constexpr size_t WS_CUM = 19 * MiB + 512 * 1024;
constexpr size_t WS_KMEAN = 20 * MiB;
constexpr size_t WS_GTAB = 21 * MiB;
constexpr size_t WS_XN = 32 * MiB;
constexpr size_t WS_Y = 32 * MiB;
constexpr size_t WS_BUFS = 64 * MiB;
constexpr size_t BUF_ELEMS = (size_t)M * 512;
constexpr size_t WS_MERGED = 64 * MiB;
constexpr size_t WS_GA = 192 * MiB, WS_GB = 224 * MiB;
constexpr size_t WS_END = 256 * MiB;

constexpr int RING_BYTES = 131072;
constexpr int LDS_BYTES = 147456;

namespace pg8 {
constexpr int BM = 256, BK = 64, HALF = 128, HTB = HALF * BK * 2, STAGE_BYTES = 8 * HTB, NXCD = 8, WGM = 8;
__host__ __device__ __forceinline__ int lds_byte(int r, int c) { const int st = (r >> 4) * 2 + (c >> 5), rr = r & 15, cc = c & 31, ob = rr * 64 + cc * 2; return st * 1024 + (ob ^ (((ob >> 9) & 1) << 5)); }
__host__ __device__ __forceinline__ void stage_rc(int b, int& R, int& C) { const int st = b / 1024, sb = b % 1024, swz = sb ^ (((sb >> 9) & 1) << 5); R = (st >> 1) * 16 + swz / 64; C = (st & 1) * 32 + (swz % 64) / 2; }
__host__ __device__ __forceinline__ int perm32(int rho) { const int n = rho >> 4, i = rho & 15; return 8 * (i >> 2) + 4 * n + (i & 3); }

struct Unit { int pm, pn; };
struct Gemm { const h16* A; const h16* Bt; int M, N, K; };

struct StaticOrder {
    int nM, nN, nwg, G, c;
    __host__ __device__ void init(int M_, int N_, int G_, int c_) { nM = M_ / BM; nN = N_ / BM; nwg = nM * nN; G = G_; c = c_; }
    __host__ __device__ bool next(int i, Unit& u) const {
        const long L = (long)i * G + c; if (L >= nwg) return false;
        int wgid = (int)L; { const int q = nwg / NXCD, r = nwg % NXCD, xcd = wgid % NXCD, off = wgid / NXCD; wgid = (xcd < r ? xcd * (q + 1) : r * (q + 1) + (xcd - r) * q) + off; }
        const int nig = WGM * nN, gid = wgid / nig, fm = gid * WGM, gsz = (nM - fm) < WGM ? (nM - fm) : WGM;
        u.pm = fm + ((wgid % nig) % gsz); u.pn = (wgid % nig) / gsz; return true;
    }
};

__device__ __forceinline__ unsigned cvt_pk_f16(float lo, float hi) { f32x2 v = {lo, hi}; f16x2 h = __builtin_convertvector(v, f16x2); return __builtin_bit_cast(unsigned, h); }

template <class Epi, class Sched, bool ALIGN_EPI = false>
__device__ __forceinline__ void gemm_phase(LAS unsigned char* lds, const Gemm g, const Sched& S, const Epi& E) {
    const int tid = threadIdx.x, wid = __builtin_amdgcn_readfirstlane(tid >> 6), lane = tid & 63, wr = wid >> 2, wc = wid & 3, fr = lane & 15, fq = lane >> 4;
    const int K = g.K, nt = K / BK;
    unsigned voffA[2], voffB[2];
#pragma unroll
    for (int i = 0; i < 2; ++i) { int R, C; stage_rc(tid * 16 + i * 8192, R, C); const int Rb = 64 * (R >> 5) + perm32(R & 31);
        voffA[i] = (unsigned)(R * K + C) * 2u; voffB[i] = (unsigned)(Rb * K + C) * 2u; }
    const size_t kstep = (size_t)(BK * 2);
    const size_t hstep = (size_t)HALF * K * 2;
    const size_t bstep = (size_t)32 * K * 2;
    const size_t tstep = 2 * hstep;
    const unsigned ldsw = (unsigned)wid * 1024u;
    const int aoff = lds_byte(wr * 64 + fr, fq * 8), boff = lds_byte(wc * 32 + fr, fq * 8);
#define PG8_SA(b, h) (((b) * 2 + (h)) * HTB)
#define PG8_SB(b, h) ((4 + (b) * 2 + (h)) * HTB)
#define PG8_STAGE(bufoff, gbase, voff) do { _Pragma("unroll") for (int _i = 0; _i < 2; ++_i) \
        __builtin_amdgcn_global_load_lds((const unsigned*)((const char*)(gbase) + (voff)[_i]), (LAS unsigned*)(lds + (bufoff) + ldsw + _i * 8192), 16, 0, 0); } while (0)
#define PG8_LDA(dst, b, h) do { _Pragma("unroll") for (int m = 0; m < 4; ++m) _Pragma("unroll") for (int k = 0; k < 2; ++k) dst[m][k] = *(const LAS f16x8*)(lds + PG8_SA(b, h) + aoff + m * 2048 + k * 1024); } while (0)
#define PG8_LDB(dst, b, h) do { _Pragma("unroll") for (int n = 0; n < 2; ++n) _Pragma("unroll") for (int k = 0; k < 2; ++k) dst[n][k] = *(const LAS f16x8*)(lds + PG8_SB(b, h) + boff + n * 2048 + k * 1024); } while (0)
#define PG8_MMA(ai, bj, At, Bt) do { __builtin_amdgcn_s_setprio(1); _Pragma("unroll") for (int m = 0; m < 4; ++m) _Pragma("unroll") for (int n = 0; n < 2; ++n) _Pragma("unroll") for (int k = 0; k < 2; ++k) \
        acc[ai][bj][m][n] = __builtin_amdgcn_mfma_f32_16x16x32_f16(Bt[n][k], At[m][k], acc[ai][bj][m][n], 0, 0, 0); __builtin_amdgcn_s_setprio(0); } while (0)
#define PG8_WAIT_V(n) asm volatile("s_waitcnt vmcnt(" #n ")" ::: "memory")
#define PG8_WAIT_L(n) asm volatile("s_waitcnt lgkmcnt(" #n ")" ::: "memory")
#define PG8_BAR __builtin_amdgcn_s_barrier()
#define PG8_SCHED __builtin_amdgcn_sched_barrier(0)
    Unit cur, nxt; int ui = 0;
    if (!S.next(0, cur)) return;
    f32x4 acc[2][2][4][2];
#pragma unroll
    for (int a = 0; a < 2; ++a)
#pragma unroll
        for (int b = 0; b < 2; ++b)
#pragma unroll
            for (int m = 0; m < 4; ++m)
#pragma unroll
                for (int n = 0; n < 2; ++n) acc[a][b][m][n] = (f32x4){0.f, 0.f, 0.f, 0.f};
    f16x8 At[4][2], B0[2][2], B1[2][2];
    const char* cA = (const char*)g.A + (size_t)cur.pm * tstep; const char* cB = (const char*)g.Bt + (size_t)cur.pn * tstep;
    PG8_STAGE(PG8_SB(0, 0), cB, voffB); PG8_STAGE(PG8_SB(0, 1), cB + bstep, voffB); PG8_STAGE(PG8_SA(0, 0), cA, voffA); PG8_STAGE(PG8_SA(0, 1), cA + hstep, voffA);
    if (wr == 1) PG8_BAR;
    PG8_WAIT_V(2); PG8_BAR;
    PG8_STAGE(PG8_SB(1, 0), cB + kstep, voffB); PG8_STAGE(PG8_SA(1, 0), cA + kstep, voffA); PG8_STAGE(PG8_SB(1, 1), cB + bstep + kstep, voffB);
    PG8_WAIT_V(6); PG8_BAR;
    for (;;) {
        const bool has_next = S.next(ui + 1, nxt);
        const char* nA = has_next ? (const char*)g.A + (size_t)nxt.pm * tstep : cA; const char* nB = has_next ? (const char*)g.Bt + (size_t)nxt.pn * tstep : cB;
        for (int t = 0; t < nt; t += 2) {
            const bool last = (t == nt - 2);
            if constexpr (Epi::MID) { if (t == nt / 2) E.mid(acc, cur, wr, wc, fr, fq); }
            const char* a1 = cA + (size_t)(t + 1) * kstep;
            const char* a2 = last ? nA : cA + (size_t)(t + 2) * kstep; const char* b2 = last ? nB : cB + (size_t)(t + 2) * kstep;
            const char* a3 = a2 + kstep; const char* b3 = b2 + kstep;
            PG8_LDB(B0, 0, 0); PG8_LDB(B1, 0, 1); PG8_SCHED; PG8_LDA(At, 0, 0); PG8_STAGE(PG8_SA(1, 1), a1 + hstep, voffA);
            PG8_WAIT_V(8); PG8_WAIT_L(0); PG8_BAR; PG8_MMA(0, 0, At, B0); PG8_MMA(0, 1, At, B1); PG8_BAR; PG8_SCHED;
            PG8_LDA(At, 0, 1); PG8_STAGE(PG8_SB(0, 0), b2, voffB); PG8_STAGE(PG8_SB(0, 1), b2 + bstep, voffB); PG8_STAGE(PG8_SA(0, 0), a2, voffA);
            PG8_WAIT_V(8); PG8_WAIT_L(0); PG8_BAR; PG8_MMA(1, 0, At, B0); PG8_MMA(1, 1, At, B1); PG8_BAR; PG8_SCHED;
            PG8_LDB(B0, 1, 0); PG8_LDB(B1, 1, 1); PG8_SCHED; PG8_LDA(At, 1, 0); PG8_STAGE(PG8_SA(0, 1), a2 + hstep, voffA);
            PG8_WAIT_V(8); PG8_WAIT_L(0); PG8_BAR; PG8_MMA(0, 0, At, B0); PG8_MMA(0, 1, At, B1); PG8_BAR; PG8_SCHED;
            PG8_LDA(At, 1, 1); PG8_STAGE(PG8_SB(1, 0), b3, voffB); PG8_STAGE(PG8_SB(1, 1), b3 + bstep, voffB); PG8_STAGE(PG8_SA(1, 0), a3, voffA);
            PG8_WAIT_V(8); PG8_WAIT_L(0); PG8_BAR; PG8_MMA(1, 0, At, B0); PG8_MMA(1, 1, At, B1); PG8_BAR; PG8_SCHED;
        }
        if constexpr (ALIGN_EPI) { if (wr == 0) PG8_BAR; }
        E(acc, cur, wr, wc, fr, fq);
        if (!has_next) break;
#pragma unroll
        for (int a = 0; a < 2; ++a)
#pragma unroll
            for (int b = 0; b < 2; ++b)
#pragma unroll
                for (int m = 0; m < 4; ++m)
#pragma unroll
                    for (int n = 0; n < 2; ++n) acc[a][b][m][n] = (f32x4){0.f, 0.f, 0.f, 0.f};
        cur = nxt; cA = nA; cB = nB; ++ui;
        if constexpr (ALIGN_EPI) { if (wr == 1) PG8_BAR; }
    }
    PG8_WAIT_V(0);
    if constexpr (!ALIGN_EPI) { if (wr == 0) PG8_BAR; }
    PG8_BAR;
#undef PG8_SA
#undef PG8_SB
#undef PG8_STAGE
#undef PG8_LDA
#undef PG8_LDB
#undef PG8_MMA
#undef PG8_WAIT_V
#undef PG8_WAIT_L
#undef PG8_BAR
#undef PG8_SCHED
}

__device__ __forceinline__ float sigmoidf_(float v) { return __builtin_amdgcn_rcpf(1.0f + __builtin_amdgcn_exp2f(-v * LOG2E)); }

struct EpiInProj {
    static constexpr bool MID = false;
    h16* bufs; h16* ga; h16* gb; const float* gtab; const float* bgate; const float* rope; float* kmean;
    __device__ __forceinline__ void operator()(f32x4 (&acc)[2][2][4][2], const Unit& u, int wr, int wc, int fr, int fq) const {
        asm volatile("" : "+v"(fr));
        const int pn = u.pn;
        if (pn >= 16) {
            const int which = pn >= 20; h16* g = which ? gb : ga;
            const int colbase = (pn - (which ? 20 : 16)) * 256 + 64 * wc + 8 * fq;
            f32x4 bv[2][2];
#pragma unroll
            for (int bj = 0; bj < 2; ++bj)
#pragma unroll
                for (int n = 0; n < 2; ++n) bv[bj][n] = *(const f32x4*)(bgate + which * 1024 + colbase + 32 * bj + 4 * n);
#pragma unroll
            for (int ai = 0; ai < 2; ++ai)
#pragma unroll
                for (int m = 0; m < 4; ++m) { const size_t row = (size_t)u.pm * 256 + 128 * ai + 64 * wr + 16 * m + fr;
#pragma unroll
                    for (int bj = 0; bj < 2; ++bj) { f32x4 v0 = acc[ai][bj][m][0] + bv[bj][0], v1 = acc[ai][bj][m][1] + bv[bj][1];
                        u32x4 w; w.x = cvt_pk_f16(sigmoidf_(v0[0]), sigmoidf_(v0[1])); w.y = cvt_pk_f16(sigmoidf_(v0[2]), sigmoidf_(v0[3]));
                        w.z = cvt_pk_f16(sigmoidf_(v1[0]), sigmoidf_(v1[1])); w.w = cvt_pk_f16(sigmoidf_(v1[2]), sigmoidf_(v1[3]));
                        *(u32x4*)(g + row * 1024 + colbase + 32 * bj) = w; } }
            return;
        }
        const int grp = pn >> 1, head = 4 * (pn & 1) + wc, b = u.pm >> 4, blk = u.pm & 15;
        const bool do_norm = (grp == 0) | (grp == 1) | (grp == 4) | (grp == 5), do_rope = (grp == 4) | (grp == 5), do_silu = (grp == 3) | (grp == 7), do_kmean = (grp == 5);
        h16* dst = bufs + (size_t)grp * BUF_ELEMS + ((size_t)(b * NH + head) * SEQ) * HD + 8 * fq;
        const int tbase = blk * 256 + 64 * wr + fr;
        f32x4 gs[2][2];
        if (do_norm) { const float* gp = gtab + 64 * ((grp & 1) + ((grp >> 2) << 1)); const float sc = (grp == 0 || grp == 4) ? QSCALE : 1.0f;
#pragma unroll
            for (int bj = 0; bj < 2; ++bj)
#pragma unroll
                for (int n = 0; n < 2; ++n) gs[bj][n] = *(const f32x4*)(gp + 32 * bj + 8 * fq + 4 * n) * sc; }
        f32x4 cs[2][2];
#pragma unroll
        for (int bj = 0; bj < 2; ++bj)
#pragma unroll
            for (int n = 0; n < 2; ++n) cs[bj][n] = (f32x4){0.f, 0.f, 0.f, 0.f};
#pragma unroll
        for (int ai = 0; ai < 2; ++ai)
#pragma unroll
            for (int m = 0; m < 4; ++m) {
                const int t = tbase + 128 * ai + 16 * m;
                f32x4 v[2][2];
#pragma unroll
                for (int bj = 0; bj < 2; ++bj)
#pragma unroll
                    for (int n = 0; n < 2; ++n) v[bj][n] = acc[ai][bj][m][n];
                if (do_norm) {
                    float ss = 0.f;
#pragma unroll
                    for (int bj = 0; bj < 2; ++bj)
#pragma unroll
                        for (int n = 0; n < 2; ++n) { const f32x4 x = v[bj][n]; ss += (x[0] * x[0] + x[1] * x[1]) + (x[2] * x[2] + x[3] * x[3]); }
                    ss += __shfl_xor(ss, 16); ss += __shfl_xor(ss, 32);
                    const float rstd = __builtin_amdgcn_rsqf(ss * (1.0f / 64.0f) + RMS_EPS);
#pragma unroll
                    for (int bj = 0; bj < 2; ++bj)
#pragma unroll
                        for (int n = 0; n < 2; ++n) v[bj][n] = v[bj][n] * rstd * gs[bj][n];
                }
                if (do_rope) {
                    f32x4 pr[2];
#pragma unroll
                    for (int n = 0; n < 2; ++n)
#pragma unroll
                        for (int e = 0; e < 4; ++e) pr[n][e] = __shfl_xor(v[0][n][e], 16);
                    if (fq < 2) {
#pragma unroll
                        for (int n = 0; n < 2; ++n) { const f32x4 c = *(const f32x4*)(rope + t * 8 + 4 * n), s = *(const f32x4*)(rope + SEQ * 8 + t * 8 + 4 * n);
                            v[0][n] = (fq == 0) ? (v[0][n] * c - pr[n] * s) : (v[0][n] * c + pr[n] * s); }
                    }
                }
                if (do_kmean) {
#pragma unroll
                    for (int bj = 0; bj < 2; ++bj)
#pragma unroll
                        for (int n = 0; n < 2; ++n) cs[bj][n] += v[bj][n];
                }
                if (do_silu) {
#pragma unroll
                    for (int bj = 0; bj < 2; ++bj)
#pragma unroll
                        for (int n = 0; n < 2; ++n)
#pragma unroll
                            for (int e = 0; e < 4; ++e) v[bj][n][e] = v[bj][n][e] * sigmoidf_(v[bj][n][e]);
                }
#pragma unroll
                for (int bj = 0; bj < 2; ++bj) { u32x4 w; w.x = cvt_pk_f16(v[bj][0][0], v[bj][0][1]); w.y = cvt_pk_f16(v[bj][0][2], v[bj][0][3]); w.z = cvt_pk_f16(v[bj][1][0], v[bj][1][1]); w.w = cvt_pk_f16(v[bj][1][2], v[bj][1][3]);
                    *(u32x4*)(dst + (size_t)t * HD + 32 * bj) = w; }
            }
        if (do_kmean) {
#pragma unroll
            for (int bj = 0; bj < 2; ++bj)
#pragma unroll
                for (int n = 0; n < 2; ++n)
#pragma unroll
                    for (int e = 0; e < 4; ++e) { float s = cs[bj][n][e]; s += __shfl_xor(s, 1); s += __shfl_xor(s, 2); s += __shfl_xor(s, 4); s += __shfl_xor(s, 8);
                        if (fr == 0) atomicAdd(kmean + ((size_t)(b * NH + head) * 16 + blk) * HD + 32 * bj + 8 * fq + 4 * n + e, s * (1.0f / 256.0f)); }
        }
    }
};

struct EpiMerge {
    static constexpr bool MID = true;
    const h16* ga; const h16* gb; h16* out;
    __device__ __forceinline__ void mid(f32x4 (&acc)[2][2][4][2], const Unit& u, int wr, int wc, int fr, int fq) const {
        asm volatile("" : "+v"(fr));
        const int col0 = u.pn * 256 + 64 * wc + 8 * fq;
#pragma unroll
        for (int ai = 0; ai < 2; ++ai)
#pragma unroll
            for (int m = 0; m < 4; ++m) { const size_t row = (size_t)u.pm * 256 + 128 * ai + 64 * wr + 16 * m + fr;
#pragma unroll
                for (int bj = 0; bj < 2; ++bj) { const f16x8 a = *(const f16x8*)(ga + row * 1024 + col0 + 32 * bj), bb = *(const f16x8*)(gb + row * 1024 + col0 + 32 * bj);
#pragma unroll
                    for (int n = 0; n < 2; ++n)
#pragma unroll
                        for (int e = 0; e < 4; ++e) acc[ai][bj][m][n][e] *= (float)a[4 * n + e] * __builtin_amdgcn_rcpf((float)bb[4 * n + e]); }
                asm volatile("" ::: "memory"); }
    }
    __device__ __forceinline__ void operator()(f32x4 (&acc)[2][2][4][2], const Unit& u, int wr, int wc, int fr, int fq) const {
        asm volatile("" : "+v"(fr));
        const int col0 = u.pn * 256 + 64 * wc + 8 * fq;
#pragma unroll
        for (int ai = 0; ai < 2; ++ai)
#pragma unroll
            for (int m = 0; m < 4; ++m) { const size_t row = (size_t)u.pm * 256 + 128 * ai + 64 * wr + 16 * m + fr;
#pragma unroll
                for (int bj = 0; bj < 2; ++bj) { const f16x8 bb = *(const f16x8*)(gb + row * 1024 + col0 + 32 * bj);
                    const f32x4 v0 = acc[ai][bj][m][0], v1 = acc[ai][bj][m][1]; u32x4 w;
                    w.x = cvt_pk_f16(v0[0] * (float)bb[0], v0[1] * (float)bb[1]); w.y = cvt_pk_f16(v0[2] * (float)bb[2], v0[3] * (float)bb[3]);
                    w.z = cvt_pk_f16(v1[0] * (float)bb[4], v1[1] * (float)bb[5]); w.w = cvt_pk_f16(v1[2] * (float)bb[6], v1[3] * (float)bb[7]);
                    *(u32x4*)(out + row * 1024 + col0 + 32 * bj) = w; } }
    }
};

struct EpiOut {
    static constexpr bool MID = false;
    const float* x; float* out;
    __device__ __forceinline__ void operator()(f32x4 (&acc)[2][2][4][2], const Unit& u, int wr, int wc, int fr, int fq) const {
        asm volatile("" : "+v"(fr));
        const int col0 = u.pn * 256 + 64 * wc + 8 * fq;
#pragma unroll
        for (int ai = 0; ai < 2; ++ai)
#pragma unroll
            for (int m = 0; m < 4; ++m) { const size_t off = ((size_t)u.pm * 256 + 128 * ai + 64 * wr + 16 * m + fr) * 1024 + col0;
#pragma unroll
                for (int bj = 0; bj < 2; ++bj)
#pragma unroll
                    for (int n = 0; n < 2; ++n) { const f32x4 xv = *(const f32x4*)(x + off + 32 * bj + 4 * n); *(f32x4*)(out + off + 32 * bj + 4 * n) = xv + acc[ai][bj][m][n]; } }
    }
};
}

namespace att {
__device__ __forceinline__ int crow(int r, int hi) { return (r & 3) + 8 * (r >> 2) + 4 * hi; }
typedef short v4i16_t __attribute__((ext_vector_type(4)));
__device__ __forceinline__ s16x4 vtr(const LAS unsigned char* p) { return __builtin_bit_cast(s16x4, __builtin_amdgcn_ds_read_tr16_b64_v4i16((LAS v4i16_t*)p)); }
constexpr int L_K = 0, L_V = 16384, L_CB = 32768, L_WSF = 33280, L_OST = 35328, L_SEL = 68096, L_KM = 69120, L_END = 73216;
constexpr float THR = 8.0f;

template <int TYPE>
__device__ __forceinline__ void attn_unit(LAS unsigned char* lds, int b, int h, int qb, const h16* __restrict__ Qg, const h16* __restrict__ Kg, const h16* __restrict__ Vg,
                                          const h16* __restrict__ Zg, h16* Y, const float* __restrict__ cum, const float* __restrict__ kmean) {
    const int tid = threadIdx.x, lane = tid & 63, r32 = lane & 31, hi = lane >> 5; const int wid = __builtin_amdgcn_readfirstlane(tid >> 6);
    const size_t headoff = (size_t)(b * NH + h) * SEQ * HD;
    const h16* Qh = Qg + headoff; const h16* Kh = Kg + headoff; const h16* Vh = Vg + headoff; const h16* Zh = Zg + headoff;
    const int q0 = qb * 256;
    LAS float* CB = (LAS float*)(lds + L_CB);
    LAS float* WSF = (LAS float*)(lds + L_WSF) + wid * 64;
    LAS h16* OST = (LAS h16*)(lds + L_OST) + wid * 2048;
    LAS unsigned* SEL = (LAS unsigned*)(lds + L_SEL);
    LAS float* KM = (LAS float*)(lds + L_KM);
    unsigned selm = 0u;
    if (TYPE == 1) {
        const float* kmp = kmean + (size_t)(b * NH + h) * 16 * HD;
        for (int i = tid; i < qb * HD; i += 512) KM[i] = kmp[i];
        __syncthreads();
        if (tid < 256) {
            unsigned mask = 0u;
            if (qb <= 3) mask = (1u << qb) - 1u;
            else {
                float qv[64];
                const f16x8* qp = (const f16x8*)(Qh + (size_t)(q0 + tid) * HD);
#pragma unroll
                for (int c = 0; c < 8; ++c) { const f16x8 t8 = qp[c];
#pragma unroll
                    for (int e = 0; e < 8; ++e) qv[8 * c + e] = (float)t8[e]; }
                float b0 = -INFINITY, b1 = -INFINITY, b2 = -INFINITY; int i0 = 0, i1 = 0, i2 = 0;
                for (int n = 0; n < qb; ++n) {
                    float gsum = 0.f;
#pragma unroll
                    for (int d = 0; d < 64; ++d) gsum = __builtin_fmaf(qv[d], KM[n * HD + d], gsum);
                    if (gsum > b0) { b2 = b1; i2 = i1; b1 = b0; i1 = i0; b0 = gsum; i0 = n; }
                    else if (gsum > b1) { b2 = b1; i2 = i1; b1 = gsum; i1 = n; }
                    else if (gsum > b2) { b2 = gsum; i2 = n; }
                }
                mask = (1u << i0) | (1u << i1) | (1u << i2);
            }
            SEL[tid] = mask;
        }
        __syncthreads();
        selm = SEL[wid * 32 + r32];
    }
    const int jend = 4 * qb + 4, jstart = 0;
    f16x8 qr[4];
    { const h16* Qw = Qh + (size_t)(q0 + wid * 32 + r32) * HD;
#pragma unroll
      for (int d0 = 0; d0 < 4; ++d0) qr[d0] = *(const f16x8*)(Qw + d0 * 16 + hi * 8); }
    const float* cumh = cum + (size_t)(b * NH + h) * SEQ;
    const float cref = (TYPE == 0) ? cumh[q0 + 255] : 0.f;
    u32x4 kreg, vreg; float cbreg = 0.f;
#define A_LOADG(j) do { kreg = *(const u32x4*)(Kh + (size_t)(64 * (j) + lane) * HD + 8 * wid); \
        vreg = *(const u32x4*)(Vh + (size_t)(64 * (j) + 16 * (wid & 3) + (lane >> 2)) * HD + 32 * (wid >> 2) + 8 * (lane & 3)); \
        if (TYPE == 0 && tid < 64) cbreg = (cref - cumh[64 * (j) + tid]) * LOG2E; } while (0)
#define A_STOREL(buf) do { *(LAS u32x4*)(lds + L_K + (buf) * 8192 + wid * 1024 + lane * 16) = kreg; *(LAS u32x4*)(lds + L_V + (buf) * 8192 + wid * 1024 + lane * 16) = vreg; \
        if (TYPE == 0 && tid < 64) CB[(buf) * 64 + tid] = cbreg; } while (0)
    float mhat = -1e30f, l_reg = 0.f; f32x16 o[2]; o[0] = f32x16{}; o[1] = f32x16{};
    const int qrel = wid * 32 + r32;
    A_LOADG(jstart); A_STOREL(jstart & 1);
    __syncthreads();
    for (int j = jstart; j < jend; ++j) {
        const int buf = j & 1;
        if (j + 1 < jend) A_LOADG(j + 1);
        bool active = true; const int jb = j >> 2;
        if (TYPE == 1 && jb != qb) active = __any((int)((selm >> jb) & 1u)) != 0;
        if (active) {
            f32x16 p0 = f32x16{}, p1 = f32x16{};
            const LAS unsigned char* kb = lds + L_K + buf * 8192 + hi * 1024 + r32 * 16;
#pragma unroll
            for (int d0 = 0; d0 < 4; ++d0) { const f16x8 k0 = *(const LAS f16x8*)(kb + d0 * 2048), k1 = *(const LAS f16x8*)(kb + d0 * 2048 + 512);
                p0 = __builtin_amdgcn_mfma_f32_32x32x16_f16(k0, qr[d0], p0, 0, 0, 0); p1 = __builtin_amdgcn_mfma_f32_32x32x16_f16(k1, qr[d0], p1, 0, 0, 0); }
            if (TYPE == 0) {
#pragma unroll
                for (int g4 = 0; g4 < 4; ++g4) { const f32x4 c0 = *(const LAS f32x4*)(CB + buf * 64 + 8 * g4 + 4 * hi), c1 = *(const LAS f32x4*)(CB + buf * 64 + 32 + 8 * g4 + 4 * hi);
#pragma unroll
                    for (int e = 0; e < 4; ++e) { p0[4 * g4 + e] += c0[e]; p1[4 * g4 + e] += c1[e]; } }
            }
            if (TYPE == 1 && jb != qb) { if (!((selm >> jb) & 1u)) {
#pragma unroll
                for (int r = 0; r < 16; ++r) { p0[r] = -INFINITY; p1[r] = -INFINITY; } } }
            if (j >= 4 * qb) { const int kb0 = 64 * (j - 4 * qb) + 4 * hi;
#pragma unroll
                for (int r = 0; r < 16; ++r) { const int kv = kb0 + (r & 3) + 8 * (r >> 2); if (kv > qrel) p0[r] = -INFINITY; if (kv + 32 > qrel) p1[r] = -INFINITY; } }
            float rm = fmaxf(p0[0], p1[0]);
#pragma unroll
            for (int r = 1; r < 16; ++r) rm = fmaxf(rm, fmaxf(p0[r], p1[r]));
            rm = fmaxf(rm, __shfl_xor(rm, 32));
            if (__any(rm > mhat + THR)) {
                const float mn = fmaxf(mhat, rm); const float f = __builtin_amdgcn_exp2f(mhat - mn); mhat = mn; l_reg *= f;
                if (hi == 0) WSF[r32] = f;
#pragma unroll
                for (int g4 = 0; g4 < 4; ++g4) { const f32x4 fv = *(const LAS f32x4*)(WSF + 8 * g4 + 4 * hi);
#pragma unroll
                    for (int e = 0; e < 4; ++e) { o[0][4 * g4 + e] *= fv[e]; o[1][4 * g4 + e] *= fv[e]; } }
            }
            float sacc = 0.f;
#pragma unroll
            for (int r = 0; r < 16; ++r) { p0[r] = __builtin_amdgcn_exp2f(p0[r] - mhat); p1[r] = __builtin_amdgcn_exp2f(p1[r] - mhat); sacc += p0[r] + p1[r]; }
            l_reg += sacc;
            u32x4 pw[4];
#pragma unroll
            for (int ks = 0; ks < 2; ++ks) {
                pw[ks] = (u32x4){pg8::cvt_pk_f16(p0[8 * ks], p0[8 * ks + 1]), pg8::cvt_pk_f16(p0[8 * ks + 2], p0[8 * ks + 3]), pg8::cvt_pk_f16(p0[8 * ks + 4], p0[8 * ks + 5]), pg8::cvt_pk_f16(p0[8 * ks + 6], p0[8 * ks + 7])};
                pw[2 + ks] = (u32x4){pg8::cvt_pk_f16(p1[8 * ks], p1[8 * ks + 1]), pg8::cvt_pk_f16(p1[8 * ks + 2], p1[8 * ks + 3]), pg8::cvt_pk_f16(p1[8 * ks + 4], p1[8 * ks + 5]), pg8::cvt_pk_f16(p1[8 * ks + 6], p1[8 * ks + 7])};
            }
            const LAS unsigned char* vp = lds + L_V + buf * 8192 + ((lane >> 4) & 1) * 32 + (lane & 3) * 8 + (4 * hi + ((lane & 15) >> 2)) * 64;
#pragma unroll
            for (int d0 = 0; d0 < 2; ++d0)
#pragma unroll
                for (int ks = 0; ks < 4; ++ks) { const s16x4 lo = vtr(vp + d0 * 4096 + ks * 1024), hh = vtr(vp + d0 * 4096 + ks * 1024 + 512);
                    const f16x8 vf = __builtin_bit_cast(f16x8, (short __attribute__((ext_vector_type(8)))){lo[0], lo[1], lo[2], lo[3], hh[0], hh[1], hh[2], hh[3]});
                    o[d0] = __builtin_amdgcn_mfma_f32_32x32x16_f16(__builtin_bit_cast(f16x8, pw[ks]), vf, o[d0], 0, 0, 0); }
        }
        if (j + 1 < jend) A_STOREL((j + 1) & 1);
        __syncthreads();
    }
#undef A_LOADG
#undef A_STOREL
    l_reg += __shfl_xor(l_reg, 32);
    if (hi == 0) WSF[32 + r32] = l_reg;
    float rli[16];
#pragma unroll
    for (int g4 = 0; g4 < 4; ++g4) { const f32x4 lv = *(const LAS f32x4*)(WSF + 32 + 8 * g4 + 4 * hi);
#pragma unroll
        for (int e = 0; e < 4; ++e) rli[4 * g4 + e] = 1.0f / lv[e]; }
#pragma unroll
    for (int r = 0; r < 16; ++r) { const int orow = crow(r, hi);
#pragma unroll
        for (int d0 = 0; d0 < 2; ++d0) OST[orow * 64 + d0 * 32 + r32] = (h16)(o[d0][r] * rli[r]); }
#pragma unroll
    for (int i = 0; i < 4; ++i) { const int row = i * 8 + (lane >> 3), ch = lane & 7;
        const f16x8 ov = *(const LAS f16x8*)(OST + row * 64 + ch * 8);
        const f16x8 zv = *(const f16x8*)(Zh + (size_t)(q0 + wid * 32 + row) * HD + ch * 8);
        u32x4 w; w.x = pg8::cvt_pk_f16((float)ov[0] * (float)zv[0], (float)ov[1] * (float)zv[1]); w.y = pg8::cvt_pk_f16((float)ov[2] * (float)zv[2], (float)ov[3] * (float)zv[3]);
        w.z = pg8::cvt_pk_f16((float)ov[4] * (float)zv[4], (float)ov[5] * (float)zv[5]); w.w = pg8::cvt_pk_f16((float)ov[6] * (float)zv[6], (float)ov[7] * (float)zv[7]);
        *(u32x4*)(Y + ((size_t)b * SEQ + q0 + wid * 32 + row) * 1024 + TYPE * 512 + h * HD + ch * 8) = w; }
    __syncthreads();
}
}

__device__ __forceinline__ float wave_sum(float v) {
#pragma unroll
    for (int o = 1; o < 64; o <<= 1) v += __shfl_xor(v, o);
    return v;
}
__device__ __forceinline__ void p0_transpose_item(const float* W, int ldw, h16* WT, int ldt, int nblk, LAS float* scr, int item, int lane) {
    const int kb = item / nblk, nb = item % nblk, k0 = 64 * kb, n0 = 32 * nb;
#pragma unroll 8
    for (int i = 0; i < 32; ++i) { const int kk = 2 * i + (lane >> 5); scr[kk * 33 + (lane & 31)] = W[(size_t)(k0 + kk) * ldw + n0 + (lane & 31)]; }
    asm volatile("s_waitcnt lgkmcnt(0)" ::: "memory");
    const int c = lane & 7;
#pragma unroll
    for (int j = 0; j < 4; ++j) { const int n = (lane >> 3) + 8 * j; const LAS float* s = scr + (8 * c) * 33 + n;
        u32x4 o; o.x = pg8::cvt_pk_f16(s[0 * 33], s[1 * 33]); o.y = pg8::cvt_pk_f16(s[2 * 33], s[3 * 33]); o.z = pg8::cvt_pk_f16(s[4 * 33], s[5 * 33]); o.w = pg8::cvt_pk_f16(s[6 * 33], s[7 * 33]);
        *(u32x4*)(WT + (size_t)(n0 + n) * ldt + k0 + 8 * c) = o; }
    asm volatile("s_waitcnt lgkmcnt(0)" ::: "memory");
}
__device__ __forceinline__ void sincos_d(double a, double& s, double& c) {
    const double kq = rint(a * 0.63661977236758134308);
    double r = fma(-kq, 1.57079632679489655800e+00, a); r = fma(-kq, 6.12323399573676603587e-17, r);
    const int q = ((int)kq) & 3; const double r2 = r * r;
    const double sp = r * (1.0 + r2 * (-1.0 / 6 + r2 * (1.0 / 120 + r2 * (-1.0 / 5040 + r2 * (1.0 / 362880 + r2 * (-1.0 / 39916800 + r2 * (1.0 / 6227020800.0 + r2 * (-1.0 / 1307674368000.0))))))));
    const double cp = 1.0 + r2 * (-0.5 + r2 * (1.0 / 24 + r2 * (-1.0 / 720 + r2 * (1.0 / 40320 + r2 * (-1.0 / 3628800 + r2 * (1.0 / 479001600 + r2 * (-1.0 / 87178291200.0 + r2 * (1.0 / 20922789888000.0))))))));
    s = (q == 0) ? sp : (q == 1) ? cp : (q == 2) ? -sp : -cp;
    c = (q == 0) ? cp : (q == 1) ? -sp : (q == 2) ? -cp : sp;
}

struct Args { const float* in[12]; float* out; unsigned char* ws; int ph_lo, ph_hi; };

__global__ void __launch_bounds__(NWAVES * 64, 2) fwd(Args args) {
    extern __shared__ __attribute__((aligned(16))) unsigned char lds_raw[];
    LAS unsigned char* lds = (LAS unsigned char*)lds_raw;
    const int tid = threadIdx.x, lane = tid & 63, wave = __builtin_amdgcn_readfirstlane(tid >> 6);
    const int G = gridDim.x; const int bx = blockIdx.x; const int vcu = (G % 8 == 0) ? (bx % 8) * (G / 8) + bx / 8 : bx;
    unsigned char* ws = args.ws;
    const float* x = args.in[0]; const float* norm_g = args.in[1]; const float* w_in = args.in[2]; const float* b_f = args.in[3]; const float* b_gate = args.in[4];
    const float* w_fox = args.in[9]; const float* w_moba = args.in[10]; const float* w_out = args.in[11];
    h16* Win_t = (h16*)(ws + WS_WIN); h16* Wcat_t = (h16*)(ws + WS_WCAT); h16* Wout_t = (h16*)(ws + WS_WOUT);
    float* rope = (float*)(ws + WS_ROPE); float* logf_ = (float*)(ws + WS_LOGF); float* cum = (float*)(ws + WS_CUM); float* kmean = (float*)(ws + WS_KMEAN); float* gtab = (float*)(ws + WS_GTAB);
    h16* XN = (h16*)(ws + WS_XN); h16* Y = (h16*)(ws + WS_Y); h16* bufs = (h16*)(ws + WS_BUFS); h16* MERGED = (h16*)(ws + WS_MERGED);
    h16* GA = (h16*)(ws + WS_GA); h16* GB = (h16*)(ws + WS_GB);
    const int lo = args.ph_lo, hi_ = args.ph_hi;
    cooperative_groups::grid_group grid_ = cooperative_groups::this_grid();
#ifndef PHASE_MASK
#define PHASE_MASK 31
#endif
#define IN(k) (((PHASE_MASK >> (k)) & 1) && lo <= (k) && (k) < hi_)
#define GRID_BAR(k) do { if (IN(k) && IN((k) + 1)) grid_.sync(); } while (0)

    if (IN(0)) {
        LAS float* scr = (LAS float*)(lds + wave * 16384);
        const int gw = vcu * NWAVES + wave, NGW = G * NWAVES;
        constexpr int I_IN = (DM / 64) * (IN_WG / 32), I_F = (512 / 64) * (DM / 32), I_O = (DM / 64) * (DM / 32);
        constexpr int NITEMS = I_IN + 2 * I_F + I_O;
        for (int it = gw; it < NITEMS; it += NGW) {
            int r = it;
            if (r < I_IN) { p0_transpose_item(w_in, IN_W, Win_t, DM, IN_WG / 32, scr, r, lane); continue; } r -= I_IN;
            if (r < I_F) { p0_transpose_item(w_fox, DM, Wcat_t, DM, DM / 32, scr, r, lane); continue; } r -= I_F;
            if (r < I_F) { p0_transpose_item(w_moba, DM, Wcat_t + 512, DM, DM / 32, scr, r, lane); continue; } r -= I_F;
            p0_transpose_item(w_out, DM, Wout_t, DM, DM / 32, scr, r, lane);
        }
        { const int gid = bx * 512 + tid;
          if (gid < BATCH * NH * 16 * HD) kmean[gid] = 0.f;
          if (gid < 256) { const int wch = gid >> 6; const float* src = args.in[5 + wch]; gtab[gid] = src[gid & 63]; }
          if (gid < SEQ * 8) { const int pos = gid >> 3, i = gid & 7;
              const float invf = (i == 0) ? 1.0f : (i == 1) ? 0.1939227432012558f : (i == 2) ? 0.03760603070259094f : (i == 3) ? 0.007292664609849453f : (i == 4) ? 0.0014142135623842478f
                               : (i == 5) ? 0.00027424818836152554f : (i == 6) ? 5.3182957344688475e-05f : 1.0313385246263351e-05f;
              const float ang = (float)pos * invf; double s, c; sincos_d((double)ang, s, c); rope[gid] = (float)c; rope[SEQ * 8 + gid] = (float)s; } }
        f32x4 gv[4]; f32x4 gw0[4][4], gw1[4][4];
#pragma unroll
        for (int j = 0; j < 4; ++j) { gv[j] = *(const f32x4*)(norm_g + 256 * j + 4 * lane);
#pragma unroll
            for (int e = 0; e < 4; ++e) { const float* wp = w_in + (size_t)(256 * j + 4 * lane + e) * IN_W + IN_WG; gw0[j][e] = *(const f32x4*)wp * gv[j][e]; gw1[j][e] = *(const f32x4*)(wp + 4) * gv[j][e]; } }
        const float bfl = (lane < 8) ? b_f[lane] : 0.f;
        for (int m = gw; m < M; m += NGW) {
            const f32x4* xr = (const f32x4*)(x + (size_t)m * DM) + lane;
            f32x4 v[4]; float ss = 0.f; f32x4 d0 = {0.f, 0.f, 0.f, 0.f}, d1 = {0.f, 0.f, 0.f, 0.f};
#pragma unroll
            for (int j = 0; j < 4; ++j) { v[j] = xr[64 * j]; ss += (v[j].x * v[j].x + v[j].y * v[j].y) + (v[j].z * v[j].z + v[j].w * v[j].w);
#pragma unroll
                for (int e = 0; e < 4; ++e) { d0 += gw0[j][e] * v[j][e]; d1 += gw1[j][e] * v[j][e]; } }
            ss = wave_sum(ss);
            const float rstd = 1.0f / sqrtf(ss * (1.0f / DM) + RMS_EPS);
            float dots[8] = {d0[0], d0[1], d0[2], d0[3], d1[0], d1[1], d1[2], d1[3]};
            float mine = 0.f;
#pragma unroll
            for (int hh = 0; hh < 8; ++hh) { const float t = wave_sum(dots[hh]); if (lane == hh) mine = t; }
            if (lane < 8) { const float z = mine * rstd + bfl; const float lf = fminf(z, 0.f) - log1pf(expf(-fabsf(z)));
                const int bb = m >> 12, t = m & 4095; logf_[(size_t)(bb * NH + lane) * SEQ + t] = lf; }
            u32x2* o8 = (u32x2*)(XN + (size_t)m * DM) + lane;
#pragma unroll
            for (int j = 0; j < 4; ++j) { const f32x4 hv = v[j] * rstd * gv[j]; u32x2 w; w.x = pg8::cvt_pk_f16(hv[0], hv[1]); w.y = pg8::cvt_pk_f16(hv[2], hv[3]); o8[64 * j] = w; }
        }
    }

    GRID_BAR(0);

    if (IN(1)) {
        if (bx < BATCH * NH) {
            const float* lf = logf_ + (size_t)bx * SEQ + tid * 8; const f32x4 a = *(const f32x4*)lf, b4 = *(const f32x4*)(lf + 4);
            double pre[8]; double s = 0.0; const float vv[8] = {a[0], a[1], a[2], a[3], b4[0], b4[1], b4[2], b4[3]};
#pragma unroll
            for (int i = 0; i < 8; ++i) { s += (double)vv[i]; pre[i] = s; }
            double incl = s;
#pragma unroll
            for (int o = 1; o < 64; o <<= 1) { const double t = __shfl_up(incl, o); if (lane >= o) incl += t; }
            LAS double* wt = (LAS double*)lds;
            if (lane == 63) wt[wave] = incl;
            __syncthreads();
            double off = incl - s;
            for (int w = 0; w < wave; ++w) off += wt[w];
            float* cp = cum + (size_t)bx * SEQ + tid * 8;
            *(f32x4*)cp = (f32x4){(float)(off + pre[0]), (float)(off + pre[1]), (float)(off + pre[2]), (float)(off + pre[3])};
            *(f32x4*)(cp + 4) = (f32x4){(float)(off + pre[4]), (float)(off + pre[5]), (float)(off + pre[6]), (float)(off + pre[7])};
            __syncthreads();
        }
        pg8::Gemm g{XN, Win_t, M, IN_WG, DM}; pg8::StaticOrder S; S.init(M, IN_WG, G, bx);
        pg8::EpiInProj E{bufs, GA, GB, gtab, b_gate, rope, kmean};
        pg8::gemm_phase<pg8::EpiInProj, pg8::StaticOrder, true>(lds, g, S, E);
    }

    GRID_BAR(1);

    if (IN(2)) {
        const int bh = vcu >> 3, s = vcu & 7, b = bh >> 3, h = bh & 7;
        if (G == 256) {
#pragma unroll 1
            for (int i = 0; i < 4; ++i) {
                const int qb = (i & 1) ? 15 - s : s;
                if (i < 2) att::attn_unit<0>(lds, b, h, qb, bufs + 0 * BUF_ELEMS, bufs + 1 * BUF_ELEMS, bufs + 2 * BUF_ELEMS, bufs + 3 * BUF_ELEMS, Y, cum, kmean);
                else       att::attn_unit<1>(lds, b, h, qb, bufs + 4 * BUF_ELEMS, bufs + 5 * BUF_ELEMS, bufs + 6 * BUF_ELEMS, bufs + 7 * BUF_ELEMS, Y, cum, kmean);
            }
        }
    }

    GRID_BAR(2);

    if (IN(3)) {
        pg8::Gemm g{Y, Wcat_t, M, DM, DM}; pg8::StaticOrder S; S.init(M, DM, G, bx);
        pg8::EpiMerge E{GA, GB, MERGED};
        pg8::gemm_phase<pg8::EpiMerge, pg8::StaticOrder, false>(lds, g, S, E);
    }

    GRID_BAR(3);

    if (IN(4)) {
        pg8::Gemm g{MERGED, Wout_t, M, DM, DM}; pg8::StaticOrder S; S.init(M, DM, G, bx);
        pg8::EpiOut E{x, args.out};
        pg8::gemm_phase<pg8::EpiOut, pg8::StaticOrder, false>(lds, g, S, E);
    }
#undef IN
#undef GRID_BAR
}

extern "C" void kernel_launch(void* const* d_in, const int* in_sizes, int n_in, void* d_out, int out_size, void* d_ws, size_t ws_size, hipStream_t stream) {
    static int grid = 0;
    if (grid == 0) {
        if (n_in != 12 || in_sizes[0] != M * DM || out_size != M * DM || ws_size < WS_END) { fprintf(stderr, "kernel_launch: unexpected shapes (n_in %d, in0 %d, out %d, ws %zu)\n", n_in, n_in > 0 ? in_sizes[0] : -1, out_size, ws_size); grid = -1; return; }
        if (hipFuncSetAttribute((const void*)fwd, hipFuncAttributeMaxDynamicSharedMemorySize, LDS_BYTES) != hipSuccess) { fprintf(stderr, "kernel_launch: hipFuncSetAttribute failed\n"); grid = -1; return; }
        int dev = 0, cus = 0, per_cu = 0; (void)hipGetDevice(&dev); (void)hipDeviceGetAttribute(&cus, hipDeviceAttributeMultiprocessorCount, dev);
        if (hipOccupancyMaxActiveBlocksPerMultiprocessor(&per_cu, (const void*)fwd, NWAVES * 64, LDS_BYTES) != hipSuccess || per_cu < 1) { fprintf(stderr, "kernel_launch: occupancy query says %d blocks per CU\n", per_cu); grid = -1; return; }
        grid = cus;
        if (grid != 256) fprintf(stderr, "kernel_launch: %d CUs (built for 256)\n", grid);
    }
    if (grid < 0) return;
    Args a{};
    for (int i = 0; i < 12; ++i) a.in[i] = (const float*)d_in[i];
    a.out = (float*)d_out; a.ws = (unsigned char*)d_ws; a.ph_lo = 0; a.ph_hi = 5;
    void* kargs[] = {&a};
    const hipError_t e = hipLaunchCooperativeKernel((const void*)fwd, dim3(grid), dim3(NWAVES * 64), kargs, LDS_BYTES, stream);
    if (e != hipSuccess) fprintf(stderr, "kernel_launch: cooperative launch failed: %s (grid %d)\n", hipGetErrorString(e), grid);
}
```

```cpp
#include <hip/hip_runtime.h>
#include <cstdio>
#include <cstdint>

#define LAS __attribute__((address_space(3)))
typedef _Float16 h16;
typedef _Float16 f16x8 __attribute__((ext_vector_type(8)));
typedef _Float16 f16x2 __attribute__((ext_vector_type(2)));
typedef float f32x2 __attribute__((ext_vector_type(2)));
typedef float f32x4 __attribute__((ext_vector_type(4)));
typedef float f32x16 __attribute__((ext_vector_type(16)));
typedef unsigned u32x4 __attribute__((ext_vector_type(4)));
typedef unsigned u32x2 __attribute__((ext_vector_type(2)));
typedef short s16x4 __attribute__((ext_vector_type(4)));

constexpr int BATCH = 4, SEQ = 4096, DM = 1024, NH = 8, HD = 64, M = BATCH * SEQ;
constexpr int IN_W = 6152, IN_WG = 6144;
constexpr float RMS_EPS = 1e-6f;
constexpr float LOG2E = 1.4426950408889634f;
constexpr float QSCALE = 0.125f * 1.4426950408889634f;
constexpr int NWAVES = 8;

constexpr size_t MiB = 1u << 20;
constexpr size_t WS_CTL = 0, CTL_ZERO_BYTES = 64 * 1024;
constexpr size_t WS_WIN = 2 * MiB;
constexpr size_t WS_WCAT = 14 * MiB;
constexpr size_t WS_WOUT = 16 * MiB;
constexpr size_t WS_ROPE = 18 * MiB;
constexpr size_t WS_LOGF = 19 * MiB;
constexpr size_t WS_CUM = 19 * MiB + 512 * 1024;
constexpr size_t WS_KMEAN = 20 * MiB;
constexpr size_t WS_GTAB = 21 * MiB;
constexpr size_t WS_XN = 32 * MiB;
constexpr size_t WS_Y = 32 * MiB;
constexpr size_t WS_BUFS = 64 * MiB;
constexpr size_t BUF_ELEMS = (size_t)M * 512;
constexpr size_t WS_MERGED = 64 * MiB;
constexpr size_t WS_GA = 192 * MiB, WS_GB = 224 * MiB;
constexpr size_t WS_END = 256 * MiB;

constexpr int RING_BYTES = 131072;
constexpr int LDS_BYTES = 147456;

namespace pg8 {
constexpr int BM = 256, BK = 64, HALF = 128, HTB = HALF * BK * 2, STAGE_BYTES = 8 * HTB, NXCD = 8, WGM = 8;
__host__ __device__ __forceinline__ int lds_byte(int r, int c) { const int st = (r >> 4) * 2 + (c >> 5), rr = r & 15, cc = c & 31, ob = rr * 64 + cc * 2; return st * 1024 + (ob ^ (((ob >> 9) & 1) << 5)); }
__host__ __device__ __forceinline__ void stage_rc(int b, int& R, int& C) { const int st = b / 1024, sb = b % 1024, swz = sb ^ (((sb >> 9) & 1) << 5); R = (st >> 1) * 16 + swz / 64; C = (st & 1) * 32 + (swz % 64) / 2; }
__host__ __device__ __forceinline__ int perm32(int rho) { const int n = rho >> 4, i = rho & 15; return 8 * (i >> 2) + 4 * n + (i & 3); }

struct Unit { int pm, pn; };
struct Gemm { const h16* A; const h16* Bt; int M, N, K; };

struct StaticOrder {
    int nM, nN, nwg, G, c;
    __host__ __device__ void init(int M_, int N_, int G_, int c_) { nM = M_ / BM; nN = N_ / BM; nwg = nM * nN; G = G_; c = c_; }
    __host__ __device__ bool next(int i, Unit& u) const {
        const long L = (long)i * G + c; if (L >= nwg) return false;
        int wgid = (int)L; { const int q = nwg / NXCD, r = nwg % NXCD, xcd = wgid % NXCD, off = wgid / NXCD; wgid = (xcd < r ? xcd * (q + 1) : r * (q + 1) + (xcd - r) * q) + off; }
        const int nig = WGM * nN, gid = wgid / nig, fm = gid * WGM, gsz = (nM - fm) < WGM ? (nM - fm) : WGM;
        u.pm = fm + ((wgid % nig) % gsz); u.pn = (wgid % nig) / gsz; return true;
    }
};

__device__ __forceinline__ unsigned cvt_pk_f16(float lo, float hi) { f32x2 v = {lo, hi}; f16x2 h = __builtin_convertvector(v, f16x2); return __builtin_bit_cast(unsigned, h); }

template <class Epi, class Sched, bool ALIGN_EPI = false>
__device__ __forceinline__ void gemm_phase(LAS unsigned char* lds, const Gemm g, const Sched& S, const Epi& E) {
    const int tid = threadIdx.x, wid = __builtin_amdgcn_readfirstlane(tid >> 6), lane = tid & 63, wr = wid >> 2, wc = wid & 3, fr = lane & 15, fq = lane >> 4;
    const int K = g.K, nt = K / BK;
    unsigned voffA[2], voffB[2];
#pragma unroll
    for (int i = 0; i < 2; ++i) { int R, C; stage_rc(tid * 16 + i * 8192, R, C); const int Rb = 64 * (R >> 5) + perm32(R & 31);
        voffA[i] = (unsigned)(R * K + C) * 2u; voffB[i] = (unsigned)(Rb * K + C) * 2u; }
    const size_t kstep = (size_t)(BK * 2);
    const size_t hstep = (size_t)HALF * K * 2;
    const size_t bstep = (size_t)32 * K * 2;
    const size_t tstep = 2 * hstep;
    const unsigned ldsw = (unsigned)wid * 1024u;
    const int aoff = lds_byte(wr * 64 + fr, fq * 8), boff = lds_byte(wc * 32 + fr, fq * 8);
#define PG8_SA(b, h) (((b) * 2 + (h)) * HTB)
#define PG8_SB(b, h) ((4 + (b) * 2 + (h)) * HTB)
#define PG8_STAGE(bufoff, gbase, voff) do { _Pragma("unroll") for (int _i = 0; _i < 2; ++_i) \
        __builtin_amdgcn_global_load_lds((const unsigned*)((const char*)(gbase) + (voff)[_i]), (LAS unsigned*)(lds + (bufoff) + ldsw + _i * 8192), 16, 0, 0); } while (0)
#define PG8_LDA(dst, b, h) do { _Pragma("unroll") for (int m = 0; m < 4; ++m) _Pragma("unroll") for (int k = 0; k < 2; ++k) dst[m][k] = *(const LAS f16x8*)(lds + PG8_SA(b, h) + aoff + m * 2048 + k * 1024); } while (0)
#define PG8_LDB(dst, b, h) do { _Pragma("unroll") for (int n = 0; n < 2; ++n) _Pragma("unroll") for (int k = 0; k < 2; ++k) dst[n][k] = *(const LAS f16x8*)(lds + PG8_SB(b, h) + boff + n * 2048 + k * 1024); } while (0)
#define PG8_MMA(ai, bj, At, Bt) do { __builtin_amdgcn_s_setprio(1); _Pragma("unroll") for (int m = 0; m < 4; ++m) _Pragma("unroll") for (int n = 0; n < 2; ++n) _Pragma("unroll") for (int k = 0; k < 2; ++k) \
        acc[ai][bj][m][n] = __builtin_amdgcn_mfma_f32_16x16x32_f16(Bt[n][k], At[m][k], acc[ai][bj][m][n], 0, 0, 0); __builtin_amdgcn_s_setprio(0); } while (0)
#define PG8_WAIT_V(n) asm volatile("s_waitcnt vmcnt(" #n ")" ::: "memory")
#define PG8_WAIT_L(n) asm volatile("s_waitcnt lgkmcnt(" #n ")" ::: "memory")
#define PG8_BAR __builtin_amdgcn_s_barrier()
#define PG8_SCHED __builtin_amdgcn_sched_barrier(0)
    Unit cur, nxt; int ui = 0;
    if (!S.next(0, cur)) return;
    f32x4 acc[2][2][4][2];
#pragma unroll
    for (int a = 0; a < 2; ++a)
#pragma unroll
        for (int b = 0; b < 2; ++b)
#pragma unroll
            for (int m = 0; m < 4; ++m)
#pragma unroll
                for (int n = 0; n < 2; ++n) acc[a][b][m][n] = (f32x4){0.f, 0.f, 0.f, 0.f};
    f16x8 At[4][2], B0[2][2], B1[2][2];
    const char* cA = (const char*)g.A + (size_t)cur.pm * tstep; const char* cB = (const char*)g.Bt + (size_t)cur.pn * tstep;
    PG8_STAGE(PG8_SB(0, 0), cB, voffB); PG8_STAGE(PG8_SB(0, 1), cB + bstep, voffB); PG8_STAGE(PG8_SA(0, 0), cA, voffA); PG8_STAGE(PG8_SA(0, 1), cA + hstep, voffA);
    if (wr == 1) PG8_BAR;
    PG8_WAIT_V(2); PG8_BAR;
    PG8_STAGE(PG8_SB(1, 0), cB + kstep, voffB); PG8_STAGE(PG8_SA(1, 0), cA + kstep, voffA); PG8_STAGE(PG8_SB(1, 1), cB + bstep + kstep, voffB);
    PG8_WAIT_V(6); PG8_BAR;
    for (;;) {
        const bool has_next = S.next(ui + 1, nxt);
        const char* nA = has_next ? (const char*)g.A + (size_t)nxt.pm * tstep : cA; const char* nB = has_next ? (const char*)g.Bt + (size_t)nxt.pn * tstep : cB;
        for (int t = 0; t < nt; t += 2) {
            const bool last = (t == nt - 2);
            if constexpr (Epi::MID) { if (t == nt / 2) E.mid(acc, cur, wr, wc, fr, fq); }
            const char* a1 = cA + (size_t)(t + 1) * kstep;
            const char* a2 = last ? nA : cA + (size_t)(t + 2) * kstep; const char* b2 = last ? nB : cB + (size_t)(t + 2) * kstep;
            const char* a3 = a2 + kstep; const char* b3 = b2 + kstep;
            PG8_LDB(B0, 0, 0); PG8_LDB(B1, 0, 1); PG8_SCHED; PG8_LDA(At, 0, 0); PG8_STAGE(PG8_SA(1, 1), a1 + hstep, voffA);
            PG8_WAIT_V(8); PG8_WAIT_L(0); PG8_BAR; PG8_MMA(0, 0, At, B0); PG8_MMA(0, 1, At, B1); PG8_BAR; PG8_SCHED;
            PG8_LDA(At, 0, 1); PG8_STAGE(PG8_SB(0, 0), b2, voffB); PG8_STAGE(PG8_SB(0, 1), b2 + bstep, voffB); PG8_STAGE(PG8_SA(0, 0), a2, voffA);
            PG8_WAIT_V(8); PG8_WAIT_L(0); PG8_BAR; PG8_MMA(1, 0, At, B0); PG8_MMA(1, 1, At, B1); PG8_BAR; PG8_SCHED;
            PG8_LDB(B0, 1, 0); PG8_LDB(B1, 1, 1); PG8_SCHED; PG8_LDA(At, 1, 0); PG8_STAGE(PG8_SA(0, 1), a2 + hstep, voffA);
            PG8_WAIT_V(8); PG8_WAIT_L(0); PG8_BAR; PG8_MMA(0, 0, At, B0); PG8_MMA(0, 1, At, B1); PG8_BAR; PG8_SCHED;
            PG8_LDA(At, 1, 1); PG8_STAGE(PG8_SB(1, 0), b3, voffB); PG8_STAGE(PG8_SB(1, 1), b3 + bstep, voffB); PG8_STAGE(PG8_SA(1, 0), a3, voffA);
            PG8_WAIT_V(8); PG8_WAIT_L(0); PG8_BAR; PG8_MMA(1, 0, At, B0); PG8_MMA(1, 1, At, B1); PG8_BAR; PG8_SCHED;
        }
        if constexpr (ALIGN_EPI) { if (wr == 0) PG8_BAR; }
        E(acc, cur, wr, wc, fr, fq);
        if (!has_next) break;
#pragma unroll
        for (int a = 0; a < 2; ++a)
#pragma unroll
            for (int b = 0; b < 2; ++b)
#pragma unroll
                for (int m = 0; m < 4; ++m)
#pragma unroll
                    for (int n = 0; n < 2; ++n) acc[a][b][m][n] = (f32x4){0.f, 0.f, 0.f, 0.f};
        cur = nxt; cA = nA; cB = nB; ++ui;
        if constexpr (ALIGN_EPI) { if (wr == 1) PG8_BAR; }
    }
    PG8_WAIT_V(0);
    if constexpr (!ALIGN_EPI) { if (wr == 0) PG8_BAR; }
    PG8_BAR;
#undef PG8_SA
#undef PG8_SB
#undef PG8_STAGE
#undef PG8_LDA
#undef PG8_LDB
#undef PG8_MMA
#undef PG8_WAIT_V
#undef PG8_WAIT_L
#undef PG8_BAR
#undef PG8_SCHED
}

__device__ __forceinline__ float sigmoidf_(float v) { return __builtin_amdgcn_rcpf(1.0f + __builtin_amdgcn_exp2f(-v * LOG2E)); }

struct EpiInProj {
    static constexpr bool MID = false;
    h16* bufs; h16* ga; h16* gb; const float* gtab; const float* bgate; const float* rope; float* kmean;
    __device__ __forceinline__ void operator()(f32x4 (&acc)[2][2][4][2], const Unit& u, int wr, int wc, int fr, int fq) const {
        asm volatile("" : "+v"(fr));
        const int pn = u.pn;
        if (pn >= 16) {
            const int which = pn >= 20; h16* g = which ? gb : ga;
            const int colbase = (pn - (which ? 20 : 16)) * 256 + 64 * wc + 8 * fq;
            f32x4 bv[2][2];
#pragma unroll
            for (int bj = 0; bj < 2; ++bj)
#pragma unroll
                for (int n = 0; n < 2; ++n) bv[bj][n] = *(const f32x4*)(bgate + which * 1024 + colbase + 32 * bj + 4 * n);
#pragma unroll
            for (int ai = 0; ai < 2; ++ai)
#pragma unroll
                for (int m = 0; m < 4; ++m) { const size_t row = (size_t)u.pm * 256 + 128 * ai + 64 * wr + 16 * m + fr;
#pragma unroll
                    for (int bj = 0; bj < 2; ++bj) { f32x4 v0 = acc[ai][bj][m][0] + bv[bj][0], v1 = acc[ai][bj][m][1] + bv[bj][1];
                        u32x4 w; w.x = cvt_pk_f16(sigmoidf_(v0[0]), sigmoidf_(v0[1])); w.y = cvt_pk_f16(sigmoidf_(v0[2]), sigmoidf_(v0[3]));
                        w.z = cvt_pk_f16(sigmoidf_(v1[0]), sigmoidf_(v1[1])); w.w = cvt_pk_f16(sigmoidf_(v1[2]), sigmoidf_(v1[3]));
                        *(u32x4*)(g + row * 1024 + colbase + 32 * bj) = w; } }
            return;
        }
        const int grp = pn >> 1, head = 4 * (pn & 1) + wc, b = u.pm >> 4, blk = u.pm & 15;
        const bool do_norm = (grp == 0) | (grp == 1) | (grp == 4) | (grp == 5), do_rope = (grp == 4) | (grp == 5), do_silu = (grp == 3) | (grp == 7), do_kmean = (grp == 5);
        h16* dst = bufs + (size_t)grp * BUF_ELEMS + ((size_t)(b * NH + head) * SEQ) * HD + 8 * fq;
        const int tbase = blk * 256 + 64 * wr + fr;
        f32x4 gs[2][2];
        if (do_norm) { const float* gp = gtab + 64 * ((grp & 1) + ((grp >> 2) << 1)); const float sc = (grp == 0 || grp == 4) ? QSCALE : 1.0f;
#pragma unroll
            for (int bj = 0; bj < 2; ++bj)
#pragma unroll
                for (int n = 0; n < 2; ++n) gs[bj][n] = *(const f32x4*)(gp + 32 * bj + 8 * fq + 4 * n) * sc; }
        f32x4 cs[2][2];
#pragma unroll
        for (int bj = 0; bj < 2; ++bj)
#pragma unroll
            for (int n = 0; n < 2; ++n) cs[bj][n] = (f32x4){0.f, 0.f, 0.f, 0.f};
#pragma unroll
        for (int ai = 0; ai < 2; ++ai)
#pragma unroll
            for (int m = 0; m < 4; ++m) {
                const int t = tbase + 128 * ai + 16 * m;
                f32x4 v[2][2];
#pragma unroll
                for (int bj = 0; bj < 2; ++bj)
#pragma unroll
                    for (int n = 0; n < 2; ++n) v[bj][n] = acc[ai][bj][m][n];
                if (do_norm) {
                    float ss = 0.f;
#pragma unroll
                    for (int bj = 0; bj < 2; ++bj)
#pragma unroll
                        for (int n = 0; n < 2; ++n) { const f32x4 x = v[bj][n]; ss += (x[0] * x[0] + x[1] * x[1]) + (x[2] * x[2] + x[3] * x[3]); }
                    ss += __shfl_xor(ss, 16); ss += __shfl_xor(ss, 32);
                    const float rstd = __builtin_amdgcn_rsqf(ss * (1.0f / 64.0f) + RMS_EPS);
#pragma unroll
                    for (int bj = 0; bj < 2; ++bj)
#pragma unroll
                        for (int n = 0; n < 2; ++n) v[bj][n] = v[bj][n] * rstd * gs[bj][n];
                }
                if (do_rope) {
                    f32x4 pr[2];
#pragma unroll
                    for (int n = 0; n < 2; ++n)
#pragma unroll
                        for (int e = 0; e < 4; ++e) pr[n][e] = __shfl_xor(v[0][n][e], 16);
                    if (fq < 2) {
#pragma unroll
                        for (int n = 0; n < 2; ++n) { const f32x4 c = *(const f32x4*)(rope + t * 8 + 4 * n), s = *(const f32x4*)(rope + SEQ * 8 + t * 8 + 4 * n);
                            v[0][n] = (fq == 0) ? (v[0][n] * c - pr[n] * s) : (v[0][n] * c + pr[n] * s); }
                    }
                }
                if (do_kmean) {
#pragma unroll
                    for (int bj = 0; bj < 2; ++bj)
#pragma unroll
                        for (int n = 0; n < 2; ++n) cs[bj][n] += v[bj][n];
                }
                if (do_silu) {
#pragma unroll
                    for (int bj = 0; bj < 2; ++bj)
#pragma unroll
                        for (int n = 0; n < 2; ++n)
#pragma unroll
                            for (int e = 0; e < 4; ++e) v[bj][n][e] = v[bj][n][e] * sigmoidf_(v[bj][n][e]);
                }
#pragma unroll
                for (int bj = 0; bj < 2; ++bj) { u32x4 w; w.x = cvt_pk_f16(v[bj][0][0], v[bj][0][1]); w.y = cvt_pk_f16(v[bj][0][2], v[bj][0][3]); w.z = cvt_pk_f16(v[bj][1][0], v[bj][1][1]); w.w = cvt_pk_f16(v[bj][1][2], v[bj][1][3]);
                    *(u32x4*)(dst + (size_t)t * HD + 32 * bj) = w; }
            }
        if (do_kmean) {
#pragma unroll
            for (int bj = 0; bj < 2; ++bj)
#pragma unroll
                for (int n = 0; n < 2; ++n)
#pragma unroll
                    for (int e = 0; e < 4; ++e) { float s = cs[bj][n][e]; s += __shfl_xor(s, 1); s += __shfl_xor(s, 2); s += __shfl_xor(s, 4); s += __shfl_xor(s, 8);
                        if (fr == 0) atomicAdd(kmean + ((size_t)(b * NH + head) * 16 + blk) * HD + 32 * bj + 8 * fq + 4 * n + e, s * (1.0f / 256.0f)); }
        }
    }
};

struct EpiMerge {
    static constexpr bool MID = true;
    const h16* ga; const h16* gb; h16* out;
    __device__ __forceinline__ void mid(f32x4 (&acc)[2][2][4][2], const Unit& u, int wr, int wc, int fr, int fq) const {
        asm volatile("" : "+v"(fr));
        const int col0 = u.pn * 256 + 64 * wc + 8 * fq;
#pragma unroll
        for (int ai = 0; ai < 2; ++ai)
#pragma unroll
            for (int m = 0; m < 4; ++m) { const size_t row = (size_t)u.pm * 256 + 128 * ai + 64 * wr + 16 * m + fr;
#pragma unroll
                for (int bj = 0; bj < 2; ++bj) { const f16x8 a = *(const f16x8*)(ga + row * 1024 + col0 + 32 * bj), bb = *(const f16x8*)(gb + row * 1024 + col0 + 32 * bj);
#pragma unroll
                    for (int n = 0; n < 2; ++n)
#pragma unroll
                        for (int e = 0; e < 4; ++e) acc[ai][bj][m][n][e] *= (float)a[4 * n + e] * __builtin_amdgcn_rcpf((float)bb[4 * n + e]); }
                asm volatile("" ::: "memory"); }
    }
    __device__ __forceinline__ void operator()(f32x4 (&acc)[2][2][4][2], const Unit& u, int wr, int wc, int fr, int fq) const {
        asm volatile("" : "+v"(fr));
        const int col0 = u.pn * 256 + 64 * wc + 8 * fq;
#pragma unroll
        for (int ai = 0; ai < 2; ++ai)
#pragma unroll
            for (int m = 0; m < 4; ++m) { const size_t row = (size_t)u.pm * 256 + 128 * ai + 64 * wr + 16 * m + fr;
#pragma unroll
                for (int bj = 0; bj < 2; ++bj) { const f16x8 bb = *(const f16x8*)(gb + row * 1024 + col0 + 32 * bj);
                    const f32x4 v0 = acc[ai][bj][m][0], v1 = acc[ai][bj][m][1]; u32x4 w;
                    w.x = cvt_pk_f16(v0[0] * (float)bb[0], v0[1] * (float)bb[1]); w.y = cvt_pk_f16(v0[2] * (float)bb[2], v0[3] * (float)bb[3]);
                    w.z = cvt_pk_f16(v1[0] * (float)bb[4], v1[1] * (float)bb[5]); w.w = cvt_pk_f16(v1[2] * (float)bb[6], v1[3] * (float)bb[7]);
                    *(u32x4*)(out + row * 1024 + col0 + 32 * bj) = w; } }
    }
};

struct EpiOut {
    static constexpr bool MID = false;
    const float* x; float* out;
    __device__ __forceinline__ void operator()(f32x4 (&acc)[2][2][4][2], const Unit& u, int wr, int wc, int fr, int fq) const {
        asm volatile("" : "+v"(fr));
        const int col0 = u.pn * 256 + 64 * wc + 8 * fq;
#pragma unroll
        for (int ai = 0; ai < 2; ++ai)
#pragma unroll
            for (int m = 0; m < 4; ++m) { const size_t off = ((size_t)u.pm * 256 + 128 * ai + 64 * wr + 16 * m + fr) * 1024 + col0;
#pragma unroll
                for (int bj = 0; bj < 2; ++bj)
#pragma unroll
                    for (int n = 0; n < 2; ++n) { const f32x4 xv = *(const f32x4*)(x + off + 32 * bj + 4 * n); *(f32x4*)(out + off + 32 * bj + 4 * n) = xv + acc[ai][bj][m][n]; } }
    }
};
}

namespace att {
__device__ __forceinline__ int crow(int r, int hi) { return (r & 3) + 8 * (r >> 2) + 4 * hi; }
typedef short v4i16_t __attribute__((ext_vector_type(4)));
__device__ __forceinline__ s16x4 vtr(const LAS unsigned char* p) { return __builtin_bit_cast(s16x4, __builtin_amdgcn_ds_read_tr16_b64_v4i16((LAS v4i16_t*)p)); }
constexpr int L_K = 0, L_V = 16384, L_CB = 32768, L_WSF = 33280, L_OST = 35328, L_SEL = 68096, L_KM = 69120, L_END = 73216;
constexpr float THR = 8.0f;

template <int TYPE>
__device__ __forceinline__ void attn_unit(LAS unsigned char* lds, int b, int h, int qb, const h16* __restrict__ Qg, const h16* __restrict__ Kg, const h16* __restrict__ Vg,
                                          const h16* __restrict__ Zg, h16* Y, const float* __restrict__ cum, const float* __restrict__ kmean) {
    const int tid = threadIdx.x, lane = tid & 63, r32 = lane & 31, hi = lane >> 5; const int wid = __builtin_amdgcn_readfirstlane(tid >> 6);
    const size_t headoff = (size_t)(b * NH + h) * SEQ * HD;
    const h16* Qh = Qg + headoff; const h16* Kh = Kg + headoff; const h16* Vh = Vg + headoff; const h16* Zh = Zg + headoff;
    const int q0 = qb * 256;
    LAS float* CB = (LAS float*)(lds + L_CB);
    LAS float* WSF = (LAS float*)(lds + L_WSF) + wid * 64;
    LAS h16* OST = (LAS h16*)(lds + L_OST) + wid * 2048;
    LAS unsigned* SEL = (LAS unsigned*)(lds + L_SEL);
    LAS float* KM = (LAS float*)(lds + L_KM);
    unsigned selm = 0u;
    if (TYPE == 1) {
        const float* kmp = kmean + (size_t)(b * NH + h) * 16 * HD;
        for (int i = tid; i < qb * HD; i += 512) KM[i] = kmp[i];
        __syncthreads();
        if (tid < 256) {
            unsigned mask = 0u;
            if (qb <= 3) mask = (1u << qb) - 1u;
            else {
                float qv[64];
                const f16x8* qp = (const f16x8*)(Qh + (size_t)(q0 + tid) * HD);
#pragma unroll
                for (int c = 0; c < 8; ++c) { const f16x8 t8 = qp[c];
#pragma unroll
                    for (int e = 0; e < 8; ++e) qv[8 * c + e] = (float)t8[e]; }
                float b0 = -INFINITY, b1 = -INFINITY, b2 = -INFINITY; int i0 = 0, i1 = 0, i2 = 0;
                for (int n = 0; n < qb; ++n) {
                    float gsum = 0.f;
#pragma unroll
                    for (int d = 0; d < 64; ++d) gsum = __builtin_fmaf(qv[d], KM[n * HD + d], gsum);
                    if (gsum > b0) { b2 = b1; i2 = i1; b1 = b0; i1 = i0; b0 = gsum; i0 = n; }
                    else if (gsum > b1) { b2 = b1; i2 = i1; b1 = gsum; i1 = n; }
                    else if (gsum > b2) { b2 = gsum; i2 = n; }
                }
                mask = (1u << i0) | (1u << i1) | (1u << i2);
            }
            SEL[tid] = mask;
        }
        __syncthreads();
        selm = SEL[wid * 32 + r32];
    }
    const int jend = 4 * qb + 4, jstart = 0;
    f16x8 qr[4];
    { const h16* Qw = Qh + (size_t)(q0 + wid * 32 + r32) * HD;
#pragma unroll
      for (int d0 = 0; d0 < 4; ++d0) qr[d0] = *(const f16x8*)(Qw + d0 * 16 + hi * 8); }
    const float* cumh = cum + (size_t)(b * NH + h) * SEQ;
    const float cref = (TYPE == 0) ? cumh[q0 + 255] : 0.f;
    u32x4 kreg, vreg; float cbreg = 0.f;
#define A_LOADG(j) do { kreg = *(const u32x4*)(Kh + (size_t)(64 * (j) + lane) * HD + 8 * wid); \
        vreg = *(const u32x4*)(Vh + (size_t)(64 * (j) + 16 * (wid & 3) + (lane >> 2)) * HD + 32 * (wid >> 2) + 8 * (lane & 3)); \
        if (TYPE == 0 && tid < 64) cbreg = (cref - cumh[64 * (j) + tid]) * LOG2E; } while (0)
#define A_STOREL(buf) do { *(LAS u32x4*)(lds + L_K + (buf) * 8192 + wid * 1024 + lane * 16) = kreg; *(LAS u32x4*)(lds + L_V + (buf) * 8192 + wid * 1024 + lane * 16) = vreg; \
        if (TYPE == 0 && tid < 64) CB[(buf) * 64 + tid] = cbreg; } while (0)
    float mhat = -1e30f, l_reg = 0.f; f32x16 o[2]; o[0] = f32x16{}; o[1] = f32x16{};
    const int qrel = wid * 32 + r32;
    A_LOADG(jstart); A_STOREL(jstart & 1);
    __syncthreads();
    for (int j = jstart; j < jend; ++j) {
        const int buf = j & 1;
        if (j + 1 < jend) A_LOADG(j + 1);
        bool active = true; const int jb = j >> 2;
        if (TYPE == 1 && jb != qb) active = __any((int)((selm >> jb) & 1u)) != 0;
        if (active) {
            f32x16 p0 = f32x16{}, p1 = f32x16{};
            const LAS unsigned char* kb = lds + L_K + buf * 8192 + hi * 1024 + r32 * 16;
#pragma unroll
            for (int d0 = 0; d0 < 4; ++d0) { const f16x8 k0 = *(const LAS f16x8*)(kb + d0 * 2048), k1 = *(const LAS f16x8*)(kb + d0 * 2048 + 512);
                p0 = __builtin_amdgcn_mfma_f32_32x32x16_f16(k0, qr[d0], p0, 0, 0, 0); p1 = __builtin_amdgcn_mfma_f32_32x32x16_f16(k1, qr[d0], p1, 0, 0, 0); }
            if (TYPE == 0) {
#pragma unroll
                for (int g4 = 0; g4 < 4; ++g4) { const f32x4 c0 = *(const LAS f32x4*)(CB + buf * 64 + 8 * g4 + 4 * hi), c1 = *(const LAS f32x4*)(CB + buf * 64 + 32 + 8 * g4 + 4 * hi);
#pragma unroll
                    for (int e = 0; e < 4; ++e) { p0[4 * g4 + e] += c0[e]; p1[4 * g4 + e] += c1[e]; } }
            }
            if (TYPE == 1 && jb != qb) { if (!((selm >> jb) & 1u)) {
#pragma unroll
                for (int r = 0; r < 16; ++r) { p0[r] = -INFINITY; p1[r] = -INFINITY; } } }
            if (j >= 4 * qb) { const int kb0 = 64 * (j - 4 * qb) + 4 * hi;
#pragma unroll
                for (int r = 0; r < 16; ++r) { const int kv = kb0 + (r & 3) + 8 * (r >> 2); if (kv > qrel) p0[r] = -INFINITY; if (kv + 32 > qrel) p1[r] = -INFINITY; } }
            float rm = fmaxf(p0[0], p1[0]);
#pragma unroll
            for (int r = 1; r < 16; ++r) rm = fmaxf(rm, fmaxf(p0[r], p1[r]));
            rm = fmaxf(rm, __shfl_xor(rm, 32));
            if (__any(rm > mhat + THR)) {
                const float mn = fmaxf(mhat, rm); const float f = __builtin_amdgcn_exp2f(mhat - mn); mhat = mn; l_reg *= f;
                if (hi == 0) WSF[r32] = f;
#pragma unroll
                for (int g4 = 0; g4 < 4; ++g4) { const f32x4 fv = *(const LAS f32x4*)(WSF + 8 * g4 + 4 * hi);
#pragma unroll
                    for (int e = 0; e < 4; ++e) { o[0][4 * g4 + e] *= fv[e]; o[1][4 * g4 + e] *= fv[e]; } }
            }
            float sacc = 0.f;
#pragma unroll
            for (int r = 0; r < 16; ++r) { p0[r] = __builtin_amdgcn_exp2f(p0[r] - mhat); p1[r] = __builtin_amdgcn_exp2f(p1[r] - mhat); sacc += p0[r] + p1[r]; }
            l_reg += sacc;
            u32x4 pw[4];
#pragma unroll
            for (int ks = 0; ks < 2; ++ks) {
                pw[ks] = (u32x4){pg8::cvt_pk_f16(p0[8 * ks], p0[8 * ks + 1]), pg8::cvt_pk_f16(p0[8 * ks + 2], p0[8 * ks + 3]), pg8::cvt_pk_f16(p0[8 * ks + 4], p0[8 * ks + 5]), pg8::cvt_pk_f16(p0[8 * ks + 6], p0[8 * ks + 7])};
                pw[2 + ks] = (u32x4){pg8::cvt_pk_f16(p1[8 * ks], p1[8 * ks + 1]), pg8::cvt_pk_f16(p1[8 * ks + 2], p1[8 * ks + 3]), pg8::cvt_pk_f16(p1[8 * ks + 4], p1[8 * ks + 5]), pg8::cvt_pk_f16(p1[8 * ks + 6], p1[8 * ks + 7])};
            }
            const LAS unsigned char* vp = lds + L_V + buf * 8192 + ((lane >> 4) & 1) * 32 + (lane & 3) * 8 + (4 * hi + ((lane & 15) >> 2)) * 64;
#pragma unroll
            for (int d0 = 0; d0 < 2; ++d0)
#pragma unroll
                for (int ks = 0; ks < 4; ++ks) { const s16x4 lo = vtr(vp + d0 * 4096 + ks * 1024), hh = vtr(vp + d0 * 4096 + ks * 1024 + 512);
                    const f16x8 vf = __builtin_bit_cast(f16x8, (short __attribute__((ext_vector_type(8)))){lo[0], lo[1], lo[2], lo[3], hh[0], hh[1], hh[2], hh[3]});
                    o[d0] = __builtin_amdgcn_mfma_f32_32x32x16_f16(__builtin_bit_cast(f16x8, pw[ks]), vf, o[d0], 0, 0, 0); }
        }
        if (j + 1 < jend) A_STOREL((j + 1) & 1);
        __syncthreads();
    }
#undef A_LOADG
#undef A_STOREL
    l_reg += __shfl_xor(l_reg, 32);
    if (hi == 0) WSF[32 + r32] = l_reg;
    float rli[16];
#pragma unroll
    for (int g4 = 0; g4 < 4; ++g4) { const f32x4 lv = *(const LAS f32x4*)(WSF + 32 + 8 * g4 + 4 * hi);
#pragma unroll
        for (int e = 0; e < 4; ++e) rli[4 * g4 + e] = 1.0f / lv[e]; }
#pragma unroll
    for (int r = 0; r < 16; ++r) { const int orow = crow(r, hi);
#pragma unroll
        for (int d0 = 0; d0 < 2; ++d0) OST[orow * 64 + d0 * 32 + r32] = (h16)(o[d0][r] * rli[r]); }
#pragma unroll
    for (int i = 0; i < 4; ++i) { const int row = i * 8 + (lane >> 3), ch = lane & 7;
        const f16x8 ov = *(const LAS f16x8*)(OST + row * 64 + ch * 8);
        const f16x8 zv = *(const f16x8*)(Zh + (size_t)(q0 + wid * 32 + row) * HD + ch * 8);
        u32x4 w; w.x = pg8::cvt_pk_f16((float)ov[0] * (float)zv[0], (float)ov[1] * (float)zv[1]); w.y = pg8::cvt_pk_f16((float)ov[2] * (float)zv[2], (float)ov[3] * (float)zv[3]);
        w.z = pg8::cvt_pk_f16((float)ov[4] * (float)zv[4], (float)ov[5] * (float)zv[5]); w.w = pg8::cvt_pk_f16((float)ov[6] * (float)zv[6], (float)ov[7] * (float)zv[7]);
        *(u32x4*)(Y + ((size_t)b * SEQ + q0 + wid * 32 + row) * 1024 + TYPE * 512 + h * HD + ch * 8) = w; }
    __syncthreads();
}
}

#define GAS __attribute__((address_space(1)))
typedef GAS unsigned gu32;
#define RLX_AGENT __ATOMIC_RELAXED, __HIP_MEMORY_SCOPE_AGENT
#define XB_TMO      128
#define XB_XCNT(j)  (256  + 64 * (j))
#define XB_XSUB(j)  (1280 + 64 * (j))
#define XB_XGEN(j)  (2304 + 64 * (j))
#define XB_TOP      3328
#define XB_TOPGEN   3392
#define XCD_BAR_WORDS 3456
#define XB_SPIN_CAP (1u << 18)

__device__ __forceinline__ unsigned xb_ld(unsigned* p)              { return __hip_atomic_load(p, __ATOMIC_RELAXED, __HIP_MEMORY_SCOPE_AGENT); }
__device__ __forceinline__ unsigned xb_add(unsigned* p, unsigned v) { return __hip_atomic_fetch_add(p, v, __ATOMIC_RELAXED, __HIP_MEMORY_SCOPE_AGENT); }
__device__ __forceinline__ unsigned xb_xcc_id() { return (unsigned)__builtin_amdgcn_s_getreg((3 << 11) | 20) & 0xFu; }
#define XB_SPIN(cond, bar) do { unsigned _sp = 0; while (cond) { __builtin_amdgcn_s_sleep(1); \
    if ((++_sp & 255u) == 0u) { if (xb_ld(&(bar)[XB_TMO])) break; if (_sp > XB_SPIN_CAP) { atomicAdd(&(bar)[XB_TMO], 1u); break; } } } } while (0)

struct XcdBarrier {
    unsigned* bar; unsigned x;
    volatile LAS unsigned* st;
};

__device__ __forceinline__ XcdBarrier xcd_barrier_post(unsigned* bar, volatile LAS unsigned* st) {
    XcdBarrier b; b.bar = bar; b.x = xb_xcc_id(); b.st = st;
    if (threadIdx.x == 0) (void)xb_add(&bar[XB_XCNT(b.x)], 1u);
    return b;
}
__device__ __forceinline__ void xcd_barrier_complete(unsigned* bar, unsigned x, unsigned& nloc, unsigned& nx) {
    const unsigned G = gridDim.x * gridDim.y * gridDim.z;
    unsigned sum, cnt, mine, sp = 0u;
    for (;;) {
        sum = 0u; cnt = 0u; mine = 0u;
#pragma unroll
        for (unsigned j = 0; j < 16; ++j) { const unsigned c = xb_ld(&bar[XB_XCNT(j)]); sum += c; cnt += (c > 0u) ? 1u : 0u; mine = (j == x) ? c : mine; }
        if (sum == G) break;
        __builtin_amdgcn_s_sleep(1);
        if ((++sp & 255u) == 0u) { if (xb_ld(&bar[XB_TMO])) break; if (sp > XB_SPIN_CAP) { atomicAdd(&bar[XB_TMO], 1u); break; } }
    }
    nloc = mine > 0u ? mine : 1u; nx = cnt > 0u ? cnt : 1u;
}

__device__ __forceinline__ void xcd_barrier(const XcdBarrier& b) {
    asm volatile("s_waitcnt vmcnt(0)" ::: "memory");
    __syncthreads();
    if (threadIdx.x == 0) {
        unsigned* bar = b.bar;
        __builtin_amdgcn_s_waitcnt(0);
        unsigned nloc = b.st[0], nx = b.st[1];
        if (nloc == 0u) { xcd_barrier_complete(bar, b.x, nloc, nx); b.st[0] = nloc; b.st[1] = nx; }
        const unsigned old = xb_add(&bar[XB_XSUB(b.x)], 1u);
        const unsigned gen = old / nloc;
        if (old + 1u == (gen + 1u) * nloc) {
            __builtin_amdgcn_fence(__ATOMIC_RELEASE, "agent");
            asm volatile("s_waitcnt vmcnt(0)" ::: "memory");
            const unsigned og = xb_add(&bar[XB_TOP], 1u);
            const unsigned tg = og / nx;
            if (og + 1u == (tg + 1u) * nx) xb_add(&bar[XB_TOPGEN], 1u);
            else XB_SPIN(xb_ld(&bar[XB_TOPGEN]) == tg, bar);
            __builtin_amdgcn_fence(__ATOMIC_ACQUIRE, "agent");
            xb_add(&bar[XB_XGEN(b.x)], 1u);
            asm volatile("s_waitcnt vmcnt(0)" ::: "memory");
        } else {
            XB_SPIN(xb_ld(&bar[XB_XGEN(b.x)]) == gen, bar);
            __builtin_amdgcn_fence(__ATOMIC_ACQUIRE, "agent");
            asm volatile("s_waitcnt vmcnt(0)" ::: "memory");
        }
    }
    __syncthreads();
}

__device__ __forceinline__ float wave_sum(float v) {
#pragma unroll
    for (int o = 1; o < 64; o <<= 1) v += __shfl_xor(v, o);
    return v;
}
__device__ __forceinline__ void p0_transpose_item(const float* W, int ldw, h16* WT, int ldt, int nblk, LAS float* scr, int item, int lane) {
    const int kb = item / nblk, nb = item % nblk, k0 = 64 * kb, n0 = 32 * nb;
#pragma unroll 8
    for (int i = 0; i < 32; ++i) { const int kk = 2 * i + (lane >> 5); scr[kk * 33 + (lane & 31)] = W[(size_t)(k0 + kk) * ldw + n0 + (lane & 31)]; }
    asm volatile("s_waitcnt lgkmcnt(0)" ::: "memory");
    const int c = lane & 7;
#pragma unroll
    for (int j = 0; j < 4; ++j) { const int n = (lane >> 3) + 8 * j; const LAS float* s = scr + (8 * c) * 33 + n;
        u32x4 o; o.x = pg8::cvt_pk_f16(s[0 * 33], s[1 * 33]); o.y = pg8::cvt_pk_f16(s[2 * 33], s[3 * 33]); o.z = pg8::cvt_pk_f16(s[4 * 33], s[5 * 33]); o.w = pg8::cvt_pk_f16(s[6 * 33], s[7 * 33]);
        *(u32x4*)(WT + (size_t)(n0 + n) * ldt + k0 + 8 * c) = o; }
    asm volatile("s_waitcnt lgkmcnt(0)" ::: "memory");
}
__device__ __forceinline__ void sincos_d(double a, double& s, double& c) {
    const double kq = rint(a * 0.63661977236758134308);
    double r = fma(-kq, 1.57079632679489655800e+00, a); r = fma(-kq, 6.12323399573676603587e-17, r);
    const int q = ((int)kq) & 3; const double r2 = r * r;
    const double sp = r * (1.0 + r2 * (-1.0 / 6 + r2 * (1.0 / 120 + r2 * (-1.0 / 5040 + r2 * (1.0 / 362880 + r2 * (-1.0 / 39916800 + r2 * (1.0 / 6227020800.0 + r2 * (-1.0 / 1307674368000.0))))))));
    const double cp = 1.0 + r2 * (-0.5 + r2 * (1.0 / 24 + r2 * (-1.0 / 720 + r2 * (1.0 / 40320 + r2 * (-1.0 / 3628800 + r2 * (1.0 / 479001600 + r2 * (-1.0 / 87178291200.0 + r2 * (1.0 / 20922789888000.0))))))));
    s = (q == 0) ? sp : (q == 1) ? cp : (q == 2) ? -sp : -cp;
    c = (q == 0) ? cp : (q == 1) ? -sp : (q == 2) ? -cp : sp;
}

struct Args { const float* in[12]; float* out; unsigned char* ws; int ph_lo, ph_hi; };

__global__ void __launch_bounds__(NWAVES * 64, 2) fwd(Args args) {
    extern __shared__ __attribute__((aligned(16))) unsigned char lds_raw[];
    LAS unsigned char* lds = (LAS unsigned char*)lds_raw;
    const int tid = threadIdx.x, lane = tid & 63, wave = __builtin_amdgcn_readfirstlane(tid >> 6);
    const int G = gridDim.x; const int bx = blockIdx.x; const int vcu = (G % 8 == 0) ? (bx % 8) * (G / 8) + bx / 8 : bx;
    unsigned char* ws = args.ws;
    volatile LAS unsigned* MISC = (volatile LAS unsigned*)(lds + RING_BYTES);
    if (tid < 32) MISC[tid] = 0u;
    __syncthreads();
    XcdBarrier bar = xcd_barrier_post((unsigned*)(ws + WS_CTL) + 1024, MISC + 8);
    const float* x = args.in[0]; const float* norm_g = args.in[1]; const float* w_in = args.in[2]; const float* b_f = args.in[3]; const float* b_gate = args.in[4];
    const float* w_fox = args.in[9]; const float* w_moba = args.in[10]; const float* w_out = args.in[11];
    h16* Win_t = (h16*)(ws + WS_WIN); h16* Wcat_t = (h16*)(ws + WS_WCAT); h16* Wout_t = (h16*)(ws + WS_WOUT);
    float* rope = (float*)(ws + WS_ROPE); float* logf_ = (float*)(ws + WS_LOGF); float* cum = (float*)(ws + WS_CUM); float* kmean = (float*)(ws + WS_KMEAN); float* gtab = (float*)(ws + WS_GTAB);
    h16* XN = (h16*)(ws + WS_XN); h16* Y = (h16*)(ws + WS_Y); h16* bufs = (h16*)(ws + WS_BUFS); h16* MERGED = (h16*)(ws + WS_MERGED);
    h16* GA = (h16*)(ws + WS_GA); h16* GB = (h16*)(ws + WS_GB);
    const int lo = args.ph_lo, hi_ = args.ph_hi;
#ifndef PHASE_MASK
#define PHASE_MASK 31
#endif
#define IN(k) (((PHASE_MASK >> (k)) & 1) && lo <= (k) && (k) < hi_)
#define GRID_BAR(k) do { if (IN(k) && IN((k) + 1)) xcd_barrier(bar); } while (0)

    if (IN(0)) {
        LAS float* scr = (LAS float*)(lds + wave * 16384);
        const int gw = vcu * NWAVES + wave, NGW = G * NWAVES;
        constexpr int I_IN = (DM / 64) * (IN_WG / 32), I_F = (512 / 64) * (DM / 32), I_O = (DM / 64) * (DM / 32);
        constexpr int NITEMS = I_IN + 2 * I_F + I_O;
        for (int it = gw; it < NITEMS; it += NGW) {
            int r = it;
            if (r < I_IN) { p0_transpose_item(w_in, IN_W, Win_t, DM, IN_WG / 32, scr, r, lane); continue; } r -= I_IN;
            if (r < I_F) { p0_transpose_item(w_fox, DM, Wcat_t, DM, DM / 32, scr, r, lane); continue; } r -= I_F;
            if (r < I_F) { p0_transpose_item(w_moba, DM, Wcat_t + 512, DM, DM / 32, scr, r, lane); continue; } r -= I_F;
            p0_transpose_item(w_out, DM, Wout_t, DM, DM / 32, scr, r, lane);
        }
        { const int gid = bx * 512 + tid;
          if (gid < BATCH * NH * 16 * HD) kmean[gid] = 0.f;
          if (gid < 256) { const int wch = gid >> 6; const float* src = args.in[5 + wch]; gtab[gid] = src[gid & 63]; }
          if (gid < SEQ * 8) { const int pos = gid >> 3, i = gid & 7;
              const float invf = (i == 0) ? 1.0f : (i == 1) ? 0.1939227432012558f : (i == 2) ? 0.03760603070259094f : (i == 3) ? 0.007292664609849453f : (i == 4) ? 0.0014142135623842478f
                               : (i == 5) ? 0.00027424818836152554f : (i == 6) ? 5.3182957344688475e-05f : 1.0313385246263351e-05f;
              const float ang = (float)pos * invf; double s, c; sincos_d((double)ang, s, c); rope[gid] = (float)c; rope[SEQ * 8 + gid] = (float)s; } }
        f32x4 gv[4]; f32x4 gw0[4][4], gw1[4][4];
#pragma unroll
        for (int j = 0; j < 4; ++j) { gv[j] = *(const f32x4*)(norm_g + 256 * j + 4 * lane);
#pragma unroll
            for (int e = 0; e < 4; ++e) { const float* wp = w_in + (size_t)(256 * j + 4 * lane + e) * IN_W + IN_WG; gw0[j][e] = *(const f32x4*)wp * gv[j][e]; gw1[j][e] = *(const f32x4*)(wp + 4) * gv[j][e]; } }
        const float bfl = (lane < 8) ? b_f[lane] : 0.f;
        for (int m = gw; m < M; m += NGW) {
            const f32x4* xr = (const f32x4*)(x + (size_t)m * DM) + lane;
            f32x4 v[4]; float ss = 0.f; f32x4 d0 = {0.f, 0.f, 0.f, 0.f}, d1 = {0.f, 0.f, 0.f, 0.f};
#pragma unroll
            for (int j = 0; j < 4; ++j) { v[j] = xr[64 * j]; ss += (v[j].x * v[j].x + v[j].y * v[j].y) + (v[j].z * v[j].z + v[j].w * v[j].w);
#pragma unroll
                for (int e = 0; e < 4; ++e) { d0 += gw0[j][e] * v[j][e]; d1 += gw1[j][e] * v[j][e]; } }
            ss = wave_sum(ss);
            const float rstd = 1.0f / sqrtf(ss * (1.0f / DM) + RMS_EPS);
            float dots[8] = {d0[0], d0[1], d0[2], d0[3], d1[0], d1[1], d1[2], d1[3]};
            float mine = 0.f;
#pragma unroll
            for (int hh = 0; hh < 8; ++hh) { const float t = wave_sum(dots[hh]); if (lane == hh) mine = t; }
            if (lane < 8) { const float z = mine * rstd + bfl; const float lf = fminf(z, 0.f) - log1pf(expf(-fabsf(z)));
                const int bb = m >> 12, t = m & 4095; logf_[(size_t)(bb * NH + lane) * SEQ + t] = lf; }
            u32x2* o8 = (u32x2*)(XN + (size_t)m * DM) + lane;
#pragma unroll
            for (int j = 0; j < 4; ++j) { const f32x4 hv = v[j] * rstd * gv[j]; u32x2 w; w.x = pg8::cvt_pk_f16(hv[0], hv[1]); w.y = pg8::cvt_pk_f16(hv[2], hv[3]); o8[64 * j] = w; }
        }
    }

    GRID_BAR(0);

    if (IN(1)) {
        if (bx < BATCH * NH) {
            const float* lf = logf_ + (size_t)bx * SEQ + tid * 8; const f32x4 a = *(const f32x4*)lf, b4 = *(const f32x4*)(lf + 4);
            double pre[8]; double s = 0.0; const float vv[8] = {a[0], a[1], a[2], a[3], b4[0], b4[1], b4[2], b4[3]};
#pragma unroll
            for (int i = 0; i < 8; ++i) { s += (double)vv[i]; pre[i] = s; }
            double incl = s;
#pragma unroll
            for (int o = 1; o < 64; o <<= 1) { const double t = __shfl_up(incl, o); if (lane >= o) incl += t; }
            LAS double* wt = (LAS double*)lds;
            if (lane == 63) wt[wave] = incl;
            __syncthreads();
            double off = incl - s;
            for (int w = 0; w < wave; ++w) off += wt[w];
            float* cp = cum + (size_t)bx * SEQ + tid * 8;
            *(f32x4*)cp = (f32x4){(float)(off + pre[0]), (float)(off + pre[1]), (float)(off + pre[2]), (float)(off + pre[3])};
            *(f32x4*)(cp + 4) = (f32x4){(float)(off + pre[4]), (float)(off + pre[5]), (float)(off + pre[6]), (float)(off + pre[7])};
            __syncthreads();
        }
        pg8::Gemm g{XN, Win_t, M, IN_WG, DM}; pg8::StaticOrder S; S.init(M, IN_WG, G, bx);
        pg8::EpiInProj E{bufs, GA, GB, gtab, b_gate, rope, kmean};
        pg8::gemm_phase<pg8::EpiInProj, pg8::StaticOrder, true>(lds, g, S, E);
    }

    GRID_BAR(1);

    if (IN(2)) {
        const int bh = vcu >> 3, s = vcu & 7, b = bh >> 3, h = bh & 7;
        if (G == 256) {
#pragma unroll 1
            for (int i = 0; i < 4; ++i) {
                const int qb = (i & 1) ? 15 - s : s;
                if (i < 2) att::attn_unit<0>(lds, b, h, qb, bufs + 0 * BUF_ELEMS, bufs + 1 * BUF_ELEMS, bufs + 2 * BUF_ELEMS, bufs + 3 * BUF_ELEMS, Y, cum, kmean);
                else       att::attn_unit<1>(lds, b, h, qb, bufs + 4 * BUF_ELEMS, bufs + 5 * BUF_ELEMS, bufs + 6 * BUF_ELEMS, bufs + 7 * BUF_ELEMS, Y, cum, kmean);
            }
        }
    }

    GRID_BAR(2);

    if (IN(3)) {
        pg8::Gemm g{Y, Wcat_t, M, DM, DM}; pg8::StaticOrder S; S.init(M, DM, G, bx);
        pg8::EpiMerge E{GA, GB, MERGED};
        pg8::gemm_phase<pg8::EpiMerge, pg8::StaticOrder, false>(lds, g, S, E);
    }

    GRID_BAR(3);

    if (IN(4)) {
        pg8::Gemm g{MERGED, Wout_t, M, DM, DM}; pg8::StaticOrder S; S.init(M, DM, G, bx);
        pg8::EpiOut E{x, args.out};
        pg8::gemm_phase<pg8::EpiOut, pg8::StaticOrder, false>(lds, g, S, E);
    }
#undef IN
#undef GRID_BAR
}

extern "C" void kernel_launch(void* const* d_in, const int* in_sizes, int n_in, void* d_out, int out_size, void* d_ws, size_t ws_size, hipStream_t stream) {
    static int grid = 0;
    if (grid == 0) {
        if (n_in != 12 || in_sizes[0] != M * DM || out_size != M * DM || ws_size < WS_END) { fprintf(stderr, "kernel_launch: unexpected shapes (n_in %d, in0 %d, out %d, ws %zu)\n", n_in, n_in > 0 ? in_sizes[0] : -1, out_size, ws_size); grid = -1; return; }
        if (hipFuncSetAttribute((const void*)fwd, hipFuncAttributeMaxDynamicSharedMemorySize, LDS_BYTES) != hipSuccess) { fprintf(stderr, "kernel_launch: hipFuncSetAttribute failed\n"); grid = -1; return; }
        int dev = 0, cus = 0, per_cu = 0; (void)hipGetDevice(&dev); (void)hipDeviceGetAttribute(&cus, hipDeviceAttributeMultiprocessorCount, dev);
        if (hipOccupancyMaxActiveBlocksPerMultiprocessor(&per_cu, (const void*)fwd, NWAVES * 64, LDS_BYTES) != hipSuccess || per_cu < 1) { fprintf(stderr, "kernel_launch: occupancy query says %d blocks per CU\n", per_cu); grid = -1; return; }
        grid = cus;
        if (grid != 256) fprintf(stderr, "kernel_launch: %d CUs (built for 256)\n", grid);
    }
    if (grid < 0) return;
    Args a{};
    for (int i = 0; i < 12; ++i) a.in[i] = (const float*)d_in[i];
    a.out = (float*)d_out; a.ws = (unsigned char*)d_ws; a.ph_lo = 0; a.ph_hi = 5;
    if (hipMemsetAsync((char*)d_ws + WS_CTL, 0, CTL_ZERO_BYTES, stream) != hipSuccess) { fprintf(stderr, "kernel_launch: hipMemsetAsync failed\n"); return; }
    hipLaunchKernelGGL(fwd, dim3(grid), dim3(NWAVES * 64), LDS_BYTES, stream, a);
    const hipError_t e = hipPeekAtLastError();
    if (e != hipSuccess) fprintf(stderr, "kernel_launch: launch failed: %s (grid %d)\n", hipGetErrorString(e), grid);
}
```

```cpp
#include <hip/hip_runtime.h>
#include <cstdio>
#include <cstdint>

#define LAS __attribute__((address_space(3)))
typedef _Float16 h16;
typedef _Float16 f16x8 __attribute__((ext_vector_type(8)));
typedef _Float16 f16x2 __attribute__((ext_vector_type(2)));
typedef float f32x2 __attribute__((ext_vector_type(2)));
typedef float f32x4 __attribute__((ext_vector_type(4)));
typedef float f32x16 __attribute__((ext_vector_type(16)));
typedef unsigned u32x4 __attribute__((ext_vector_type(4)));
typedef unsigned u32x2 __attribute__((ext_vector_type(2)));
typedef short s16x4 __attribute__((ext_vector_type(4)));

constexpr int BATCH = 4, SEQ = 4096, DM = 1024, NH = 8, HD = 64, M = BATCH * SEQ;
constexpr int IN_W = 6152, IN_WG = 6144;
constexpr float RMS_EPS = 1e-6f;
constexpr float LOG2E = 1.4426950408889634f;
constexpr float QSCALE = 0.125f * 1.4426950408889634f;
constexpr int NWAVES = 8;

constexpr size_t MiB = 1u << 20;
constexpr size_t WS_CTL = 0, CTL_ZERO_BYTES = 64 * 1024;
constexpr size_t WS_WIN = 2 * MiB;
constexpr size_t WS_WCAT = 14 * MiB;
constexpr size_t WS_WOUT = 16 * MiB;
constexpr size_t WS_ROPE = 18 * MiB;
constexpr size_t WS_LOGF = 19 * MiB;
constexpr size_t WS_CUM = 19 * MiB + 512 * 1024;
constexpr size_t WS_KMEAN = 20 * MiB;
constexpr size_t WS_GTAB = 21 * MiB;
constexpr size_t WS_XN = 32 * MiB;
constexpr size_t WS_Y = 32 * MiB;
constexpr size_t WS_BUFS = 64 * MiB;
constexpr size_t BUF_ELEMS = (size_t)M * 512;
constexpr size_t WS_MERGED = 64 * MiB;
constexpr size_t WS_GA = 192 * MiB, WS_GB = 224 * MiB;
constexpr size_t WS_END = 256 * MiB;

constexpr int RING_BYTES = 131072;
constexpr int LDS_BYTES = 147456;

namespace pg8 {
constexpr int BM = 256, BK = 64, HALF = 128, HTB = HALF * BK * 2, STAGE_BYTES = 8 * HTB, NXCD = 8, WGM = 8;
__host__ __device__ __forceinline__ int lds_byte(int r, int c) { const int st = (r >> 4) * 2 + (c >> 5), rr = r & 15, cc = c & 31, ob = rr * 64 + cc * 2; return st * 1024 + (ob ^ (((ob >> 9) & 1) << 5)); }
__host__ __device__ __forceinline__ void stage_rc(int b, int& R, int& C) { const int st = b / 1024, sb = b % 1024, swz = sb ^ (((sb >> 9) & 1) << 5); R = (st >> 1) * 16 + swz / 64; C = (st & 1) * 32 + (swz % 64) / 2; }
__host__ __device__ __forceinline__ int perm32(int rho) { const int n = rho >> 4, i = rho & 15; return 8 * (i >> 2) + 4 * n + (i & 3); }

struct Unit { int pm, pn; };
struct Gemm { const h16* A; const h16* Bt; int M, N, K; };

struct StaticOrder {
    int nM, nN, nwg, G, c;
    __host__ __device__ void init(int M_, int N_, int G_, int c_) { nM = M_ / BM; nN = N_ / BM; nwg = nM * nN; G = G_; c = c_; }
    __host__ __device__ bool next(int i, Unit& u) const {
        const long L = (long)i * G + c; if (L >= nwg) return false;
        int wgid = (int)L; { const int q = nwg / NXCD, r = nwg % NXCD, xcd = wgid % NXCD, off = wgid / NXCD; wgid = (xcd < r ? xcd * (q + 1) : r * (q + 1) + (xcd - r) * q) + off; }
        const int nig = WGM * nN, gid = wgid / nig, fm = gid * WGM, gsz = (nM - fm) < WGM ? (nM - fm) : WGM;
        u.pm = fm + ((wgid % nig) % gsz); u.pn = (wgid % nig) / gsz; return true;
    }
};

__device__ __forceinline__ unsigned cvt_pk_f16(float lo, float hi) { f32x2 v = {lo, hi}; f16x2 h = __builtin_convertvector(v, f16x2); return __builtin_bit_cast(unsigned, h); }

template <class Epi, class Sched, bool ALIGN_EPI = false>
__device__ __forceinline__ void gemm_phase(LAS unsigned char* lds, const Gemm g, const Sched& S, const Epi& E) {
    const int tid = threadIdx.x, wid = __builtin_amdgcn_readfirstlane(tid >> 6), lane = tid & 63, wr = wid >> 2, wc = wid & 3, fr = lane & 15, fq = lane >> 4;
    const int K = g.K, nt = K / BK;
    unsigned voffA[2], voffB[2];
#pragma unroll
    for (int i = 0; i < 2; ++i) { int R, C; stage_rc(tid * 16 + i * 8192, R, C); const int Rb = 64 * (R >> 5) + perm32(R & 31);
        voffA[i] = (unsigned)(R * K + C) * 2u; voffB[i] = (unsigned)(Rb * K + C) * 2u; }
    const size_t kstep = (size_t)(BK * 2);
    const size_t hstep = (size_t)HALF * K * 2;
    const size_t bstep = (size_t)32 * K * 2;
    const size_t tstep = 2 * hstep;
    const unsigned ldsw = (unsigned)wid * 1024u;
    const int aoff = lds_byte(wr * 64 + fr, fq * 8), boff = lds_byte(wc * 32 + fr, fq * 8);
#define PG8_SA(b, h) (((b) * 2 + (h)) * HTB)
#define PG8_SB(b, h) ((4 + (b) * 2 + (h)) * HTB)
#define PG8_STAGE(bufoff, gbase, voff) do { _Pragma("unroll") for (int _i = 0; _i < 2; ++_i) \
        __builtin_amdgcn_global_load_lds((const unsigned*)((const char*)(gbase) + (voff)[_i]), (LAS unsigned*)(lds + (bufoff) + ldsw + _i * 8192), 16, 0, 0); } while (0)
#define PG8_LDA(dst, b, h) do { _Pragma("unroll") for (int m = 0; m < 4; ++m) _Pragma("unroll") for (int k = 0; k < 2; ++k) dst[m][k] = *(const LAS f16x8*)(lds + PG8_SA(b, h) + aoff + m * 2048 + k * 1024); } while (0)
#define PG8_LDB(dst, b, h) do { _Pragma("unroll") for (int n = 0; n < 2; ++n) _Pragma("unroll") for (int k = 0; k < 2; ++k) dst[n][k] = *(const LAS f16x8*)(lds + PG8_SB(b, h) + boff + n * 2048 + k * 1024); } while (0)
#define PG8_MMA(ai, bj, At, Bt) do { __builtin_amdgcn_s_setprio(1); _Pragma("unroll") for (int m = 0; m < 4; ++m) _Pragma("unroll") for (int n = 0; n < 2; ++n) _Pragma("unroll") for (int k = 0; k < 2; ++k) \
        acc[ai][bj][m][n] = __builtin_amdgcn_mfma_f32_16x16x32_f16(Bt[n][k], At[m][k], acc[ai][bj][m][n], 0, 0, 0); __builtin_amdgcn_s_setprio(0); } while (0)
#define PG8_WAIT_V(n) asm volatile("s_waitcnt vmcnt(" #n ")" ::: "memory")
#define PG8_WAIT_L(n) asm volatile("s_waitcnt lgkmcnt(" #n ")" ::: "memory")
#define PG8_BAR __builtin_amdgcn_s_barrier()
#define PG8_SCHED __builtin_amdgcn_sched_barrier(0)
    Unit cur, nxt; int ui = 0;
    if (!S.next(0, cur)) return;
    f32x4 acc[2][2][4][2];
#pragma unroll
    for (int a = 0; a < 2; ++a)
#pragma unroll
        for (int b = 0; b < 2; ++b)
#pragma unroll
            for (int m = 0; m < 4; ++m)
#pragma unroll
                for (int n = 0; n < 2; ++n) acc[a][b][m][n] = (f32x4){0.f, 0.f, 0.f, 0.f};
    f16x8 At[4][2], B0[2][2], B1[2][2];
    const char* cA = (const char*)g.A + (size_t)cur.pm * tstep; const char* cB = (const char*)g.Bt + (size_t)cur.pn * tstep;
    PG8_STAGE(PG8_SB(0, 0), cB, voffB); PG8_STAGE(PG8_SB(0, 1), cB + bstep, voffB); PG8_STAGE(PG8_SA(0, 0), cA, voffA); PG8_STAGE(PG8_SA(0, 1), cA + hstep, voffA);
    if (wr == 1) PG8_BAR;
    PG8_WAIT_V(2); PG8_BAR;
    PG8_STAGE(PG8_SB(1, 0), cB + kstep, voffB); PG8_STAGE(PG8_SA(1, 0), cA + kstep, voffA); PG8_STAGE(PG8_SB(1, 1), cB + bstep + kstep, voffB);
    PG8_WAIT_V(6); PG8_BAR;
    for (;;) {
        const bool has_next = S.next(ui + 1, nxt);
        const char* nA = has_next ? (const char*)g.A + (size_t)nxt.pm * tstep : cA; const char* nB = has_next ? (const char*)g.Bt + (size_t)nxt.pn * tstep : cB;
        for (int t = 0; t < nt; t += 2) {
            const bool last = (t == nt - 2);
            if constexpr (Epi::MID) { if (t == nt / 2) E.mid(acc, cur, wr, wc, fr, fq); }
            const char* a1 = cA + (size_t)(t + 1) * kstep;
            const char* a2 = last ? nA : cA + (size_t)(t + 2) * kstep; const char* b2 = last ? nB : cB + (size_t)(t + 2) * kstep;
            const char* a3 = a2 + kstep; const char* b3 = b2 + kstep;
            PG8_LDB(B0, 0, 0); PG8_LDB(B1, 0, 1); PG8_SCHED; PG8_LDA(At, 0, 0); PG8_STAGE(PG8_SA(1, 1), a1 + hstep, voffA);
            PG8_WAIT_V(8); PG8_WAIT_L(0); PG8_BAR; PG8_MMA(0, 0, At, B0); PG8_MMA(0, 1, At, B1); PG8_BAR; PG8_SCHED;
            PG8_LDA(At, 0, 1); PG8_STAGE(PG8_SB(0, 0), b2, voffB); PG8_STAGE(PG8_SB(0, 1), b2 + bstep, voffB); PG8_STAGE(PG8_SA(0, 0), a2, voffA);
            PG8_WAIT_V(8); PG8_WAIT_L(0); PG8_BAR; PG8_MMA(1, 0, At, B0); PG8_MMA(1, 1, At, B1); PG8_BAR; PG8_SCHED;
            PG8_LDB(B0, 1, 0); PG8_LDB(B1, 1, 1); PG8_SCHED; PG8_LDA(At, 1, 0); PG8_STAGE(PG8_SA(0, 1), a2 + hstep, voffA);
            PG8_WAIT_V(8); PG8_WAIT_L(0); PG8_BAR; PG8_MMA(0, 0, At, B0); PG8_MMA(0, 1, At, B1); PG8_BAR; PG8_SCHED;
            PG8_LDA(At, 1, 1); PG8_STAGE(PG8_SB(1, 0), b3, voffB); PG8_STAGE(PG8_SB(1, 1), b3 + bstep, voffB); PG8_STAGE(PG8_SA(1, 0), a3, voffA);
            PG8_WAIT_V(8); PG8_WAIT_L(0); PG8_BAR; PG8_MMA(1, 0, At, B0); PG8_MMA(1, 1, At, B1); PG8_BAR; PG8_SCHED;
        }
        if constexpr (ALIGN_EPI) { if (wr == 0) PG8_BAR; }
        E(acc, cur, wr, wc, fr, fq);
        if (!has_next) break;
#pragma unroll
        for (int a = 0; a < 2; ++a)
#pragma unroll
            for (int b = 0; b < 2; ++b)
#pragma unroll
                for (int m = 0; m < 4; ++m)
#pragma unroll
                    for (int n = 0; n < 2; ++n) acc[a][b][m][n] = (f32x4){0.f, 0.f, 0.f, 0.f};
        cur = nxt; cA = nA; cB = nB; ++ui;
        if constexpr (ALIGN_EPI) { if (wr == 1) PG8_BAR; }
    }
    PG8_WAIT_V(0);
    if constexpr (!ALIGN_EPI) { if (wr == 0) PG8_BAR; }
    PG8_BAR;
#undef PG8_SA
#undef PG8_SB
#undef PG8_STAGE
#undef PG8_LDA
#undef PG8_LDB
#undef PG8_MMA
#undef PG8_WAIT_V
#undef PG8_WAIT_L
#undef PG8_BAR
#undef PG8_SCHED
}

__device__ __forceinline__ float sigmoidf_(float v) { return __builtin_amdgcn_rcpf(1.0f + __builtin_amdgcn_exp2f(-v * LOG2E)); }

struct EpiInProj {
    static constexpr bool MID = false;
    h16* bufs; h16* ga; h16* gb; const float* gtab; const float* bgate; const float* rope; float* kmean;
    __device__ __forceinline__ void operator()(f32x4 (&acc)[2][2][4][2], const Unit& u, int wr, int wc, int fr, int fq) const {
        asm volatile("" : "+v"(fr));
        const int pn = u.pn;
        if (pn >= 16) {
            const int which = pn >= 20; h16* g = which ? gb : ga;
            const int colbase = (pn - (which ? 20 : 16)) * 256 + 64 * wc + 8 * fq;
            f32x4 bv[2][2];
#pragma unroll
            for (int bj = 0; bj < 2; ++bj)
#pragma unroll
                for (int n = 0; n < 2; ++n) bv[bj][n] = *(const f32x4*)(bgate + which * 1024 + colbase + 32 * bj + 4 * n);
#pragma unroll
            for (int ai = 0; ai < 2; ++ai)
#pragma unroll
                for (int m = 0; m < 4; ++m) { const size_t row = (size_t)u.pm * 256 + 128 * ai + 64 * wr + 16 * m + fr;
#pragma unroll
                    for (int bj = 0; bj < 2; ++bj) { f32x4 v0 = acc[ai][bj][m][0] + bv[bj][0], v1 = acc[ai][bj][m][1] + bv[bj][1];
                        u32x4 w; w.x = cvt_pk_f16(sigmoidf_(v0[0]), sigmoidf_(v0[1])); w.y = cvt_pk_f16(sigmoidf_(v0[2]), sigmoidf_(v0[3]));
                        w.z = cvt_pk_f16(sigmoidf_(v1[0]), sigmoidf_(v1[1])); w.w = cvt_pk_f16(sigmoidf_(v1[2]), sigmoidf_(v1[3]));
                        *(u32x4*)(g + row * 1024 + colbase + 32 * bj) = w; } }
            return;
        }
        const int grp = pn >> 1, head = 4 * (pn & 1) + wc, b = u.pm >> 4, blk = u.pm & 15;
        const bool do_norm = (grp == 0) | (grp == 1) | (grp == 4) | (grp == 5), do_rope = (grp == 4) | (grp == 5), do_silu = (grp == 3) | (grp == 7), do_kmean = (grp == 5);
        h16* dst = bufs + (size_t)grp * BUF_ELEMS + ((size_t)(b * NH + head) * SEQ) * HD + 8 * fq;
        const int tbase = blk * 256 + 64 * wr + fr;
        f32x4 gs[2][2];
        if (do_norm) { const float* gp = gtab + 64 * ((grp & 1) + ((grp >> 2) << 1)); const float sc = (grp == 0 || grp == 4) ? QSCALE : 1.0f;
#pragma unroll
            for (int bj = 0; bj < 2; ++bj)
#pragma unroll
                for (int n = 0; n < 2; ++n) gs[bj][n] = *(const f32x4*)(gp + 32 * bj + 8 * fq + 4 * n) * sc; }
        f32x4 cs[2][2];
#pragma unroll
        for (int bj = 0; bj < 2; ++bj)
#pragma unroll
            for (int n = 0; n < 2; ++n) cs[bj][n] = (f32x4){0.f, 0.f, 0.f, 0.f};
#pragma unroll
        for (int ai = 0; ai < 2; ++ai)
#pragma unroll
            for (int m = 0; m < 4; ++m) {
                const int t = tbase + 128 * ai + 16 * m;
                f32x4 v[2][2];
#pragma unroll
                for (int bj = 0; bj < 2; ++bj)
#pragma unroll
                    for (int n = 0; n < 2; ++n) v[bj][n] = acc[ai][bj][m][n];
                if (do_norm) {
                    float ss = 0.f;
#pragma unroll
                    for (int bj = 0; bj < 2; ++bj)
#pragma unroll
                        for (int n = 0; n < 2; ++n) { const f32x4 x = v[bj][n]; ss += (x[0] * x[0] + x[1] * x[1]) + (x[2] * x[2] + x[3] * x[3]); }
                    ss += __shfl_xor(ss, 16); ss += __shfl_xor(ss, 32);
                    const float rstd = __builtin_amdgcn_rsqf(ss * (1.0f / 64.0f) + RMS_EPS);
#pragma unroll
                    for (int bj = 0; bj < 2; ++bj)
#pragma unroll
                        for (int n = 0; n < 2; ++n) v[bj][n] = v[bj][n] * rstd * gs[bj][n];
                }
                if (do_rope) {
                    f32x4 pr[2];
#pragma unroll
                    for (int n = 0; n < 2; ++n)
#pragma unroll
                        for (int e = 0; e < 4; ++e) pr[n][e] = __shfl_xor(v[0][n][e], 16);
                    if (fq < 2) {
#pragma unroll
                        for (int n = 0; n < 2; ++n) { const f32x4 c = *(const f32x4*)(rope + t * 8 + 4 * n), s = *(const f32x4*)(rope + SEQ * 8 + t * 8 + 4 * n);
                            v[0][n] = (fq == 0) ? (v[0][n] * c - pr[n] * s) : (v[0][n] * c + pr[n] * s); }
                    }
                }
                if (do_kmean) {
#pragma unroll
                    for (int bj = 0; bj < 2; ++bj)
#pragma unroll
                        for (int n = 0; n < 2; ++n) cs[bj][n] += v[bj][n];
                }
                if (do_silu) {
#pragma unroll
                    for (int bj = 0; bj < 2; ++bj)
#pragma unroll
                        for (int n = 0; n < 2; ++n)
#pragma unroll
                            for (int e = 0; e < 4; ++e) v[bj][n][e] = v[bj][n][e] * sigmoidf_(v[bj][n][e]);
                }
#pragma unroll
                for (int bj = 0; bj < 2; ++bj) { u32x4 w; w.x = cvt_pk_f16(v[bj][0][0], v[bj][0][1]); w.y = cvt_pk_f16(v[bj][0][2], v[bj][0][3]); w.z = cvt_pk_f16(v[bj][1][0], v[bj][1][1]); w.w = cvt_pk_f16(v[bj][1][2], v[bj][1][3]);
                    *(u32x4*)(dst + (size_t)t * HD + 32 * bj) = w; }
            }
        if (do_kmean) {
#pragma unroll
            for (int bj = 0; bj < 2; ++bj)
#pragma unroll
                for (int n = 0; n < 2; ++n)
#pragma unroll
                    for (int e = 0; e < 4; ++e) { float s = cs[bj][n][e]; s += __shfl_xor(s, 1); s += __shfl_xor(s, 2); s += __shfl_xor(s, 4); s += __shfl_xor(s, 8);
                        if (fr == 0) atomicAdd(kmean + ((size_t)(b * NH + head) * 16 + blk) * HD + 32 * bj + 8 * fq + 4 * n + e, s * (1.0f / 256.0f)); }
        }
    }
};

struct EpiMerge {
    static constexpr bool MID = true;
    const h16* ga; const h16* gb; h16* out;
    __device__ __forceinline__ void mid(f32x4 (&acc)[2][2][4][2], const Unit& u, int wr, int wc, int fr, int fq) const {
        asm volatile("" : "+v"(fr));
        const int col0 = u.pn * 256 + 64 * wc + 8 * fq;
#pragma unroll
        for (int ai = 0; ai < 2; ++ai)
#pragma unroll
            for (int m = 0; m < 4; ++m) { const size_t row = (size_t)u.pm * 256 + 128 * ai + 64 * wr + 16 * m + fr;
#pragma unroll
                for (int bj = 0; bj < 2; ++bj) { const f16x8 a = *(const f16x8*)(ga + row * 1024 + col0 + 32 * bj), bb = *(const f16x8*)(gb + row * 1024 + col0 + 32 * bj);
#pragma unroll
                    for (int n = 0; n < 2; ++n)
#pragma unroll
                        for (int e = 0; e < 4; ++e) acc[ai][bj][m][n][e] *= (float)a[4 * n + e] * __builtin_amdgcn_rcpf((float)bb[4 * n + e]); }
                asm volatile("" ::: "memory"); }
    }
    __device__ __forceinline__ void operator()(f32x4 (&acc)[2][2][4][2], const Unit& u, int wr, int wc, int fr, int fq) const {
        asm volatile("" : "+v"(fr));
        const int col0 = u.pn * 256 + 64 * wc + 8 * fq;
#pragma unroll
        for (int ai = 0; ai < 2; ++ai)
#pragma unroll
            for (int m = 0; m < 4; ++m) { const size_t row = (size_t)u.pm * 256 + 128 * ai + 64 * wr + 16 * m + fr;
#pragma unroll
                for (int bj = 0; bj < 2; ++bj) { const f16x8 bb = *(const f16x8*)(gb + row * 1024 + col0 + 32 * bj);
                    const f32x4 v0 = acc[ai][bj][m][0], v1 = acc[ai][bj][m][1]; u32x4 w;
                    w.x = cvt_pk_f16(v0[0] * (float)bb[0], v0[1] * (float)bb[1]); w.y = cvt_pk_f16(v0[2] * (float)bb[2], v0[3] * (float)bb[3]);
                    w.z = cvt_pk_f16(v1[0] * (float)bb[4], v1[1] * (float)bb[5]); w.w = cvt_pk_f16(v1[2] * (float)bb[6], v1[3] * (float)bb[7]);
                    *(u32x4*)(out + row * 1024 + col0 + 32 * bj) = w; } }
    }
};

struct EpiOut {
    static constexpr bool MID = false;
    const float* x; float* out;
    __device__ __forceinline__ void operator()(f32x4 (&acc)[2][2][4][2], const Unit& u, int wr, int wc, int fr, int fq) const {
        asm volatile("" : "+v"(fr));
        const int col0 = u.pn * 256 + 64 * wc + 8 * fq;
#pragma unroll
        for (int ai = 0; ai < 2; ++ai)
#pragma unroll
            for (int m = 0; m < 4; ++m) { const size_t off = ((size_t)u.pm * 256 + 128 * ai + 64 * wr + 16 * m + fr) * 1024 + col0;
#pragma unroll
                for (int bj = 0; bj < 2; ++bj)
#pragma unroll
                    for (int n = 0; n < 2; ++n) { const f32x4 xv = *(const f32x4*)(x + off + 32 * bj + 4 * n); *(f32x4*)(out + off + 32 * bj + 4 * n) = xv + acc[ai][bj][m][n]; } }
    }
};
}

namespace att {
__device__ __forceinline__ int crow(int r, int hi) { return (r & 3) + 8 * (r >> 2) + 4 * hi; }
typedef short v4i16_t __attribute__((ext_vector_type(4)));
__device__ __forceinline__ s16x4 vtr(const LAS unsigned char* p) { return __builtin_bit_cast(s16x4, __builtin_amdgcn_ds_read_tr16_b64_v4i16((LAS v4i16_t*)p)); }
constexpr int L_K = 0, L_V = 16384, L_CB = 32768, L_WSF = 33280, L_OST = 35328, L_SEL = 68096, L_KM = 69120, L_END = 73216;
constexpr float THR = 8.0f;

template <int TYPE>
__device__ __forceinline__ void attn_unit(LAS unsigned char* lds, int b, int h, int qb, const h16* __restrict__ Qg, const h16* __restrict__ Kg, const h16* __restrict__ Vg,
                                          const h16* __restrict__ Zg, h16* Y, const float* __restrict__ cum, const float* __restrict__ kmean, const float* __restrict__ gtab) {
    const int tid = threadIdx.x, lane = tid & 63, r32 = lane & 31, hi = lane >> 5; const int wid = __builtin_amdgcn_readfirstlane(tid >> 6);
    const size_t headoff = (size_t)(b * NH + h) * SEQ * HD;
    const h16* Qh = Qg + headoff; const h16* Kh = Kg + headoff; const h16* Vh = Vg + headoff; const h16* Zh = Zg + headoff;
    const int q0 = qb * 256;
    LAS float* CB = (LAS float*)(lds + L_CB);
    LAS float* WSF = (LAS float*)(lds + L_WSF) + wid * 64;
    LAS h16* OST = (LAS h16*)(lds + L_OST) + wid * 2048;
    LAS unsigned* SEL = (LAS unsigned*)(lds + L_SEL);
    LAS float* KM = (LAS float*)(lds + L_KM);
    unsigned selm = 0u;
    if (TYPE == 1) {
        const float* kmp = kmean + (size_t)(b * NH + h) * 16 * HD;
        for (int i = tid; i < qb * HD; i += 512) KM[i] = kmp[i];
        __syncthreads();
        if (tid < 256) {
            unsigned mask = 0u;
            if (qb <= 3) mask = (1u << qb) - 1u;
            else {
                float qv[64];
                const f16x8* qp = (const f16x8*)(Qh + (size_t)(q0 + tid) * HD);
#pragma unroll
                for (int c = 0; c < 8; ++c) { const f16x8 t8 = qp[c];
#pragma unroll
                    for (int e = 0; e < 8; ++e) qv[8 * c + e] = (float)t8[e]; }
                float b0 = -INFINITY, b1 = -INFINITY, b2 = -INFINITY; int i0 = 0, i1 = 0, i2 = 0;
                for (int n = 0; n < qb; ++n) {
                    float gsum = 0.f;
#pragma unroll
                    for (int d = 0; d < 64; ++d) gsum = __builtin_fmaf(qv[d], KM[n * HD + d], gsum);
                    if (gsum > b0) { b2 = b1; i2 = i1; b1 = b0; i1 = i0; b0 = gsum; i0 = n; }
                    else if (gsum > b1) { b2 = b1; i2 = i1; b1 = gsum; i1 = n; }
                    else if (gsum > b2) { b2 = gsum; i2 = n; }
                }
                mask = (1u << i0) | (1u << i1) | (1u << i2);
            }
            SEL[tid] = mask;
        }
        __syncthreads();
        selm = SEL[wid * 32 + r32];
    }
    const int jend = 4 * qb + 4; int jstart = 0, jstart_w = 0;
    f16x8 qr[4];
    { const h16* Qw = Qh + (size_t)(q0 + wid * 32 + r32) * HD;
#pragma unroll
      for (int d0 = 0; d0 < 4; ++d0) qr[d0] = *(const f16x8*)(Qw + d0 * 16 + hi * 8); }
    const float* cumh = cum + (size_t)(b * NH + h) * SEQ;
    const float cref = (TYPE == 0) ? cumh[q0 + 255] : 0.f;
    if (TYPE == 0) {
        float gq = fabsf(gtab[lane]), gk = fabsf(gtab[64 + lane]);
#pragma unroll
        for (int o = 1; o < 64; o <<= 1) { gq = fmaxf(gq, __shfl_xor(gq, o)); gk = fmaxf(gk, __shfl_xor(gk, o)); }
        const float lmax2 = 8.0f * gq * gk * LOG2E * 1.02f;
        const float ce = (lane < jend) ? cumh[64 * lane + 63] : 0.f;
        const float cu = cumh[q0], cw = cumh[q0 + 32 * wid];
        const bool ok_u = (lane < jend) && ((cu - ce) * LOG2E + 2.0f * lmax2 >= -150.0f);
        const bool ok_w = (lane < jend) && ((cw - ce) * LOG2E + 2.0f * lmax2 >= -150.0f);
        const unsigned long long bu = __ballot(ok_u), bw = __ballot(ok_w);
        jstart = __builtin_amdgcn_readfirstlane(bu ? (int)__builtin_ctzll(bu) : 0); jstart_w = __builtin_amdgcn_readfirstlane(bw ? (int)__builtin_ctzll(bw) : 0);
        if (jstart > 4 * qb) jstart = 4 * qb;
    }
    u32x4 kreg, vreg; float cbreg = 0.f;
#define A_LOADG(j) do { kreg = *(const u32x4*)(Kh + (size_t)(64 * (j) + lane) * HD + 8 * wid); \
        vreg = *(const u32x4*)(Vh + (size_t)(64 * (j) + 16 * (wid & 3) + (lane >> 2)) * HD + 32 * (wid >> 2) + 8 * (lane & 3)); \
        if (TYPE == 0 && tid < 64) cbreg = (cref - cumh[64 * (j) + tid]) * LOG2E; } while (0)
#define A_STOREL(buf) do { *(LAS u32x4*)(lds + L_K + (buf) * 8192 + wid * 1024 + lane * 16) = kreg; *(LAS u32x4*)(lds + L_V + (buf) * 8192 + wid * 1024 + lane * 16) = vreg; \
        if (TYPE == 0 && tid < 64) CB[(buf) * 64 + tid] = cbreg; } while (0)
    float mhat = -1e30f, l_reg = 0.f; f32x16 o[2]; o[0] = f32x16{}; o[1] = f32x16{};
    const int qrel = wid * 32 + r32;
    A_LOADG(jstart); A_STOREL(jstart & 1);
    __syncthreads();
    for (int j = jstart; j < jend; ++j) {
        const int buf = j & 1;
        if (j + 1 < jend) A_LOADG(j + 1);
        bool active = true; const int jb = j >> 2;
        if (TYPE == 1 && jb != qb) active = __any((int)((selm >> jb) & 1u)) != 0;
        if (TYPE == 0) active = (j >= jstart_w);
        if (active) {
            f32x16 p0 = f32x16{}, p1 = f32x16{};
            const LAS unsigned char* kb = lds + L_K + buf * 8192 + hi * 1024 + r32 * 16;
#pragma unroll
            for (int d0 = 0; d0 < 4; ++d0) { const f16x8 k0 = *(const LAS f16x8*)(kb + d0 * 2048), k1 = *(const LAS f16x8*)(kb + d0 * 2048 + 512);
                p0 = __builtin_amdgcn_mfma_f32_32x32x16_f16(k0, qr[d0], p0, 0, 0, 0); p1 = __builtin_amdgcn_mfma_f32_32x32x16_f16(k1, qr[d0], p1, 0, 0, 0); }
            if (TYPE == 0) {
#pragma unroll
                for (int g4 = 0; g4 < 4; ++g4) { const f32x4 c0 = *(const LAS f32x4*)(CB + buf * 64 + 8 * g4 + 4 * hi), c1 = *(const LAS f32x4*)(CB + buf * 64 + 32 + 8 * g4 + 4 * hi);
#pragma unroll
                    for (int e = 0; e < 4; ++e) { p0[4 * g4 + e] += c0[e]; p1[4 * g4 + e] += c1[e]; } }
            }
            if (TYPE == 1 && jb != qb) { if (!((selm >> jb) & 1u)) {
#pragma unroll
                for (int r = 0; r < 16; ++r) { p0[r] = -INFINITY; p1[r] = -INFINITY; } } }
            if (j >= 4 * qb) { const int kb0 = 64 * (j - 4 * qb) + 4 * hi;
#pragma unroll
                for (int r = 0; r < 16; ++r) { const int kv = kb0 + (r & 3) + 8 * (r >> 2); if (kv > qrel) p0[r] = -INFINITY; if (kv + 32 > qrel) p1[r] = -INFINITY; } }
            float rm = fmaxf(p0[0], p1[0]);
#pragma unroll
            for (int r = 1; r < 16; ++r) rm = fmaxf(rm, fmaxf(p0[r], p1[r]));
            rm = fmaxf(rm, __shfl_xor(rm, 32));
            if (__any(rm > mhat + THR)) {
                const float mn = fmaxf(mhat, rm); const float f = __builtin_amdgcn_exp2f(mhat - mn); mhat = mn; l_reg *= f;
                if (hi == 0) WSF[r32] = f;
#pragma unroll
                for (int g4 = 0; g4 < 4; ++g4) { const f32x4 fv = *(const LAS f32x4*)(WSF + 8 * g4 + 4 * hi);
#pragma unroll
                    for (int e = 0; e < 4; ++e) { o[0][4 * g4 + e] *= fv[e]; o[1][4 * g4 + e] *= fv[e]; } }
            }
            float sacc = 0.f;
#pragma unroll
            for (int r = 0; r < 16; ++r) { p0[r] = __builtin_amdgcn_exp2f(p0[r] - mhat); p1[r] = __builtin_amdgcn_exp2f(p1[r] - mhat); sacc += p0[r] + p1[r]; }
            l_reg += sacc;
            u32x4 pw[4];
#pragma unroll
            for (int ks = 0; ks < 2; ++ks) {
                pw[ks] = (u32x4){pg8::cvt_pk_f16(p0[8 * ks], p0[8 * ks + 1]), pg8::cvt_pk_f16(p0[8 * ks + 2], p0[8 * ks + 3]), pg8::cvt_pk_f16(p0[8 * ks + 4], p0[8 * ks + 5]), pg8::cvt_pk_f16(p0[8 * ks + 6], p0[8 * ks + 7])};
                pw[2 + ks] = (u32x4){pg8::cvt_pk_f16(p1[8 * ks], p1[8 * ks + 1]), pg8::cvt_pk_f16(p1[8 * ks + 2], p1[8 * ks + 3]), pg8::cvt_pk_f16(p1[8 * ks + 4], p1[8 * ks + 5]), pg8::cvt_pk_f16(p1[8 * ks + 6], p1[8 * ks + 7])};
            }
            const LAS unsigned char* vp = lds + L_V + buf * 8192 + ((lane >> 4) & 1) * 32 + (lane & 3) * 8 + (4 * hi + ((lane & 15) >> 2)) * 64;
#pragma unroll
            for (int d0 = 0; d0 < 2; ++d0)
#pragma unroll
                for (int ks = 0; ks < 4; ++ks) { const s16x4 lo = vtr(vp + d0 * 4096 + ks * 1024), hh = vtr(vp + d0 * 4096 + ks * 1024 + 512);
                    const f16x8 vf = __builtin_bit_cast(f16x8, (short __attribute__((ext_vector_type(8)))){lo[0], lo[1], lo[2], lo[3], hh[0], hh[1], hh[2], hh[3]});
                    o[d0] = __builtin_amdgcn_mfma_f32_32x32x16_f16(__builtin_bit_cast(f16x8, pw[ks]), vf, o[d0], 0, 0, 0); }
        }
        if (j + 1 < jend) A_STOREL((j + 1) & 1);
        __syncthreads();
    }
#undef A_LOADG
#undef A_STOREL
    l_reg += __shfl_xor(l_reg, 32);
    if (hi == 0) WSF[32 + r32] = l_reg;
    float rli[16];
#pragma unroll
    for (int g4 = 0; g4 < 4; ++g4) { const f32x4 lv = *(const LAS f32x4*)(WSF + 32 + 8 * g4 + 4 * hi);
#pragma unroll
        for (int e = 0; e < 4; ++e) rli[4 * g4 + e] = 1.0f / lv[e]; }
#pragma unroll
    for (int r = 0; r < 16; ++r) { const int orow = crow(r, hi);
#pragma unroll
        for (int d0 = 0; d0 < 2; ++d0) OST[orow * 64 + d0 * 32 + r32] = (h16)(o[d0][r] * rli[r]); }
#pragma unroll
    for (int i = 0; i < 4; ++i) { const int row = i * 8 + (lane >> 3), ch = lane & 7;
        const f16x8 ov = *(const LAS f16x8*)(OST + row * 64 + ch * 8);
        const f16x8 zv = *(const f16x8*)(Zh + (size_t)(q0 + wid * 32 + row) * HD + ch * 8);
        u32x4 w; w.x = pg8::cvt_pk_f16((float)ov[0] * (float)zv[0], (float)ov[1] * (float)zv[1]); w.y = pg8::cvt_pk_f16((float)ov[2] * (float)zv[2], (float)ov[3] * (float)zv[3]);
        w.z = pg8::cvt_pk_f16((float)ov[4] * (float)zv[4], (float)ov[5] * (float)zv[5]); w.w = pg8::cvt_pk_f16((float)ov[6] * (float)zv[6], (float)ov[7] * (float)zv[7]);
        *(u32x4*)(Y + ((size_t)b * SEQ + q0 + wid * 32 + row) * 1024 + TYPE * 512 + h * HD + ch * 8) = w; }
    __syncthreads();
}
}

#define GAS __attribute__((address_space(1)))
typedef GAS unsigned gu32;
#define RLX_AGENT __ATOMIC_RELAXED, __HIP_MEMORY_SCOPE_AGENT
#define XB_TMO      128
#define XB_XCNT(j)  (256  + 64 * (j))
#define XB_XSUB(j)  (1280 + 64 * (j))
#define XB_XGEN(j)  (2304 + 64 * (j))
#define XB_TOP      3328
#define XB_TOPGEN   3392
#define XCD_BAR_WORDS 3456
#define XB_SPIN_CAP (1u << 18)

__device__ __forceinline__ unsigned xb_ld(unsigned* p)              { return __hip_atomic_load(p, __ATOMIC_RELAXED, __HIP_MEMORY_SCOPE_AGENT); }
__device__ __forceinline__ unsigned xb_add(unsigned* p, unsigned v) { return __hip_atomic_fetch_add(p, v, __ATOMIC_RELAXED, __HIP_MEMORY_SCOPE_AGENT); }
__device__ __forceinline__ unsigned xb_xcc_id() { return (unsigned)__builtin_amdgcn_s_getreg((3 << 11) | 20) & 0xFu; }
#define XB_SPIN(cond, bar) do { unsigned _sp = 0; while (cond) { __builtin_amdgcn_s_sleep(1); \
    if ((++_sp & 255u) == 0u) { if (xb_ld(&(bar)[XB_TMO])) break; if (_sp > XB_SPIN_CAP) { atomicAdd(&(bar)[XB_TMO], 1u); break; } } } } while (0)

struct XcdBarrier {
    unsigned* bar; unsigned x;
    volatile LAS unsigned* st;
};

__device__ __forceinline__ XcdBarrier xcd_barrier_post(unsigned* bar, volatile LAS unsigned* st) {
    XcdBarrier b; b.bar = bar; b.x = xb_xcc_id(); b.st = st;
    if (threadIdx.x == 0) (void)xb_add(&bar[XB_XCNT(b.x)], 1u);
    return b;
}
__device__ __forceinline__ void xcd_barrier_complete(unsigned* bar, unsigned x, unsigned& nloc, unsigned& nx) {
    const unsigned G = gridDim.x * gridDim.y * gridDim.z;
    unsigned sum, cnt, mine, sp = 0u;
    for (;;) {
        sum = 0u; cnt = 0u; mine = 0u;
#pragma unroll
        for (unsigned j = 0; j < 16; ++j) { const unsigned c = xb_ld(&bar[XB_XCNT(j)]); sum += c; cnt += (c > 0u) ? 1u : 0u; mine = (j == x) ? c : mine; }
        if (sum == G) break;
        __builtin_amdgcn_s_sleep(1);
        if ((++sp & 255u) == 0u) { if (xb_ld(&bar[XB_TMO])) break; if (sp > XB_SPIN_CAP) { atomicAdd(&bar[XB_TMO], 1u); break; } }
    }
    nloc = mine > 0u ? mine : 1u; nx = cnt > 0u ? cnt : 1u;
}

__device__ __forceinline__ void xcd_barrier(const XcdBarrier& b) {
    asm volatile("s_waitcnt vmcnt(0)" ::: "memory");
    __syncthreads();
    if (threadIdx.x == 0) {
        unsigned* bar = b.bar;
        __builtin_amdgcn_s_waitcnt(0);
        unsigned nloc = b.st[0], nx = b.st[1];
        if (nloc == 0u) { xcd_barrier_complete(bar, b.x, nloc, nx); b.st[0] = nloc; b.st[1] = nx; }
        const unsigned old = xb_add(&bar[XB_XSUB(b.x)], 1u);
        const unsigned gen = old / nloc;
        if (old + 1u == (gen + 1u) * nloc) {
            __builtin_amdgcn_fence(__ATOMIC_RELEASE, "agent");
            asm volatile("s_waitcnt vmcnt(0)" ::: "memory");
            const unsigned og = xb_add(&bar[XB_TOP], 1u);
            const unsigned tg = og / nx;
            if (og + 1u == (tg + 1u) * nx) xb_add(&bar[XB_TOPGEN], 1u);
            else XB_SPIN(xb_ld(&bar[XB_TOPGEN]) == tg, bar);
            __builtin_amdgcn_fence(__ATOMIC_ACQUIRE, "agent");
            xb_add(&bar[XB_XGEN(b.x)], 1u);
            asm volatile("s_waitcnt vmcnt(0)" ::: "memory");
        } else {
            XB_SPIN(xb_ld(&bar[XB_XGEN(b.x)]) == gen, bar);
            __builtin_amdgcn_fence(__ATOMIC_ACQUIRE, "agent");
            asm volatile("s_waitcnt vmcnt(0)" ::: "memory");
        }
    }
    __syncthreads();
}

__device__ __forceinline__ float wave_sum(float v) {
#pragma unroll
    for (int o = 1; o < 64; o <<= 1) v += __shfl_xor(v, o);
    return v;
}
__device__ __forceinline__ void p0_transpose_item(const float* W, int ldw, h16* WT, int ldt, int nblk, LAS float* scr, int item, int lane) {
    const int kb = item / nblk, nb = item % nblk, k0 = 64 * kb, n0 = 32 * nb;
#pragma unroll 8
    for (int i = 0; i < 32; ++i) { const int kk = 2 * i + (lane >> 5); scr[kk * 33 + (lane & 31)] = W[(size_t)(k0 + kk) * ldw + n0 + (lane & 31)]; }
    asm volatile("s_waitcnt lgkmcnt(0)" ::: "memory");
    const int c = lane & 7;
#pragma unroll
    for (int j = 0; j < 4; ++j) { const int n = (lane >> 3) + 8 * j; const LAS float* s = scr + (8 * c) * 33 + n;
        u32x4 o; o.x = pg8::cvt_pk_f16(s[0 * 33], s[1 * 33]); o.y = pg8::cvt_pk_f16(s[2 * 33], s[3 * 33]); o.z = pg8::cvt_pk_f16(s[4 * 33], s[5 * 33]); o.w = pg8::cvt_pk_f16(s[6 * 33], s[7 * 33]);
        *(u32x4*)(WT + (size_t)(n0 + n) * ldt + k0 + 8 * c) = o; }
    asm volatile("s_waitcnt lgkmcnt(0)" ::: "memory");
}
__device__ __forceinline__ void sincos_d(double a, double& s, double& c) {
    const double kq = rint(a * 0.63661977236758134308);
    double r = fma(-kq, 1.57079632679489655800e+00, a); r = fma(-kq, 6.12323399573676603587e-17, r);
    const int q = ((int)kq) & 3; const double r2 = r * r;
    const double sp = r * (1.0 + r2 * (-1.0 / 6 + r2 * (1.0 / 120 + r2 * (-1.0 / 5040 + r2 * (1.0 / 362880 + r2 * (-1.0 / 39916800 + r2 * (1.0 / 6227020800.0 + r2 * (-1.0 / 1307674368000.0))))))));
    const double cp = 1.0 + r2 * (-0.5 + r2 * (1.0 / 24 + r2 * (-1.0 / 720 + r2 * (1.0 / 40320 + r2 * (-1.0 / 3628800 + r2 * (1.0 / 479001600 + r2 * (-1.0 / 87178291200.0 + r2 * (1.0 / 20922789888000.0))))))));
    s = (q == 0) ? sp : (q == 1) ? cp : (q == 2) ? -sp : -cp;
    c = (q == 0) ? cp : (q == 1) ? -sp : (q == 2) ? -cp : sp;
}

struct Args { const float* in[12]; float* out; unsigned char* ws; int ph_lo, ph_hi; };

__global__ void __launch_bounds__(NWAVES * 64, 2) fwd(Args args) {
    extern __shared__ __attribute__((aligned(16))) unsigned char lds_raw[];
    LAS unsigned char* lds = (LAS unsigned char*)lds_raw;
    const int tid = threadIdx.x, lane = tid & 63, wave = __builtin_amdgcn_readfirstlane(tid >> 6);
    const int G = gridDim.x; const int bx = blockIdx.x; const int vcu = (G % 8 == 0) ? (bx % 8) * (G / 8) + bx / 8 : bx;
    unsigned char* ws = args.ws;
    volatile LAS unsigned* MISC = (volatile LAS unsigned*)(lds + RING_BYTES);
    if (tid < 32) MISC[tid] = 0u;
    __syncthreads();
    XcdBarrier bar = xcd_barrier_post((unsigned*)(ws + WS_CTL) + 1024, MISC + 8);
    const float* x = args.in[0]; const float* norm_g = args.in[1]; const float* w_in = args.in[2]; const float* b_f = args.in[3]; const float* b_gate = args.in[4];
    const float* w_fox = args.in[9]; const float* w_moba = args.in[10]; const float* w_out = args.in[11];
    h16* Win_t = (h16*)(ws + WS_WIN); h16* Wcat_t = (h16*)(ws + WS_WCAT); h16* Wout_t = (h16*)(ws + WS_WOUT);
    float* rope = (float*)(ws + WS_ROPE); float* logf_ = (float*)(ws + WS_LOGF); float* cum = (float*)(ws + WS_CUM); float* kmean = (float*)(ws + WS_KMEAN); float* gtab = (float*)(ws + WS_GTAB);
    h16* XN = (h16*)(ws + WS_XN); h16* Y = (h16*)(ws + WS_Y); h16* bufs = (h16*)(ws + WS_BUFS); h16* MERGED = (h16*)(ws + WS_MERGED);
    h16* GA = (h16*)(ws + WS_GA); h16* GB = (h16*)(ws + WS_GB);
    const int lo = args.ph_lo, hi_ = args.ph_hi;
#ifndef REP0
#define REP0 1
#endif
#ifndef REP1
#define REP1 1
#endif
#ifndef REP2F
#define REP2F 1
#endif
#ifndef REP2M
#define REP2M 1
#endif
#ifndef REP3
#define REP3 1
#endif
#ifndef REP4
#define REP4 1
#endif
#ifndef PHASE_MASK
#define PHASE_MASK 31
#endif
#define IN(k) (((PHASE_MASK >> (k)) & 1) && lo <= (k) && (k) < hi_)
#define GRID_BAR(k) do { if (IN(k) && IN((k) + 1)) xcd_barrier(bar); } while (0)

    if (IN(0)) for (int rep_ = 0; rep_ < REP0; ++rep_) {
        LAS float* scr = (LAS float*)(lds + wave * 16384);
        const int gw = vcu * NWAVES + wave, NGW = G * NWAVES;
        constexpr int I_IN = (DM / 64) * (IN_WG / 32), I_F = (512 / 64) * (DM / 32), I_O = (DM / 64) * (DM / 32);
        constexpr int NITEMS = I_IN + 2 * I_F + I_O;
        for (int it = gw; it < NITEMS; it += NGW) {
            int r = it;
            if (r < I_IN) { p0_transpose_item(w_in, IN_W, Win_t, DM, IN_WG / 32, scr, r, lane); continue; } r -= I_IN;
            if (r < I_F) { p0_transpose_item(w_fox, DM, Wcat_t, DM, DM / 32, scr, r, lane); continue; } r -= I_F;
            if (r < I_F) { p0_transpose_item(w_moba, DM, Wcat_t + 512, DM, DM / 32, scr, r, lane); continue; } r -= I_F;
            p0_transpose_item(w_out, DM, Wout_t, DM, DM / 32, scr, r, lane);
        }
        { const int gid = bx * 512 + tid;
          if (gid < BATCH * NH * 16 * HD) kmean[gid] = 0.f;
          if (gid < 256) { const int wch = gid >> 6; const float* src = args.in[5 + wch]; gtab[gid] = src[gid & 63]; }
          if (gid < SEQ * 8) { const int pos = gid >> 3, i = gid & 7;
              const float invf = (i == 0) ? 1.0f : (i == 1) ? 0.1939227432012558f : (i == 2) ? 0.03760603070259094f : (i == 3) ? 0.007292664609849453f : (i == 4) ? 0.0014142135623842478f
                               : (i == 5) ? 0.00027424818836152554f : (i == 6) ? 5.3182957344688475e-05f : 1.0313385246263351e-05f;
              const float ang = (float)pos * invf; double s, c; sincos_d((double)ang, s, c); rope[gid] = (float)c; rope[SEQ * 8 + gid] = (float)s; } }
        f32x4 gv[4]; f32x4 gw0[4][4], gw1[4][4];
#pragma unroll
        for (int j = 0; j < 4; ++j) { gv[j] = *(const f32x4*)(norm_g + 256 * j + 4 * lane);
#pragma unroll
            for (int e = 0; e < 4; ++e) { const float* wp = w_in + (size_t)(256 * j + 4 * lane + e) * IN_W + IN_WG; gw0[j][e] = *(const f32x4*)wp * gv[j][e]; gw1[j][e] = *(const f32x4*)(wp + 4) * gv[j][e]; } }
        const float bfl = (lane < 8) ? b_f[lane] : 0.f;
        for (int m = gw; m < M; m += NGW) {
            const f32x4* xr = (const f32x4*)(x + (size_t)m * DM) + lane;
            f32x4 v[4]; float ss = 0.f; f32x4 d0 = {0.f, 0.f, 0.f, 0.f}, d1 = {0.f, 0.f, 0.f, 0.f};
#pragma unroll
            for (int j = 0; j < 4; ++j) { v[j] = xr[64 * j]; ss += (v[j].x * v[j].x + v[j].y * v[j].y) + (v[j].z * v[j].z + v[j].w * v[j].w);
#pragma unroll
                for (int e = 0; e < 4; ++e) { d0 += gw0[j][e] * v[j][e]; d1 += gw1[j][e] * v[j][e]; } }
            ss = wave_sum(ss);
            const float rstd = 1.0f / sqrtf(ss * (1.0f / DM) + RMS_EPS);
            float dots[8] = {d0[0], d0[1], d0[2], d0[3], d1[0], d1[1], d1[2], d1[3]};
            float mine = 0.f;
#pragma unroll
            for (int hh = 0; hh < 8; ++hh) { const float t = wave_sum(dots[hh]); if (lane == hh) mine = t; }
            if (lane < 8) { const float z = mine * rstd + bfl; const float lf = fminf(z, 0.f) - log1pf(expf(-fabsf(z)));
                const int bb = m >> 12, t = m & 4095; logf_[(size_t)(bb * NH + lane) * SEQ + t] = lf; }
            u32x2* o8 = (u32x2*)(XN + (size_t)m * DM) + lane;
#pragma unroll
            for (int j = 0; j < 4; ++j) { const f32x4 hv = v[j] * rstd * gv[j]; u32x2 w; w.x = pg8::cvt_pk_f16(hv[0], hv[1]); w.y = pg8::cvt_pk_f16(hv[2], hv[3]); o8[64 * j] = w; }
        }
    }

    GRID_BAR(0);

    if (IN(1)) for (int rep_ = 0; rep_ < REP1; ++rep_) {
        if (bx < BATCH * NH) {
            const float* lf = logf_ + (size_t)bx * SEQ + tid * 8; const f32x4 a = *(const f32x4*)lf, b4 = *(const f32x4*)(lf + 4);
            double pre[8]; double s = 0.0; const float vv[8] = {a[0], a[1], a[2], a[3], b4[0], b4[1], b4[2], b4[3]};
#pragma unroll
            for (int i = 0; i < 8; ++i) { s += (double)vv[i]; pre[i] = s; }
            double incl = s;
#pragma unroll
            for (int o = 1; o < 64; o <<= 1) { const double t = __shfl_up(incl, o); if (lane >= o) incl += t; }
            LAS double* wt = (LAS double*)lds;
            if (lane == 63) wt[wave] = incl;
            __syncthreads();
            double off = incl - s;
            for (int w = 0; w < wave; ++w) off += wt[w];
            float* cp = cum + (size_t)bx * SEQ + tid * 8;
            *(f32x4*)cp = (f32x4){(float)(off + pre[0]), (float)(off + pre[1]), (float)(off + pre[2]), (float)(off + pre[3])};
            *(f32x4*)(cp + 4) = (f32x4){(float)(off + pre[4]), (float)(off + pre[5]), (float)(off + pre[6]), (float)(off + pre[7])};
            __syncthreads();
        }
        pg8::Gemm g{XN, Win_t, M, IN_WG, DM}; pg8::StaticOrder S; S.init(M, IN_WG, G, bx);
        pg8::EpiInProj E{bufs, GA, GB, gtab, b_gate, rope, kmean};
        pg8::gemm_phase<pg8::EpiInProj, pg8::StaticOrder, true>(lds, g, S, E);
    }

    GRID_BAR(1);

    if (IN(2)) {
        const int bh = vcu >> 3, s = vcu & 7, b = bh >> 3, h = bh & 7;
        if (G == 256) {
#pragma unroll 1
            for (int i = 0; i < 2 * REP2F + 2 * REP2M; ++i) {
                const int qb = (i & 1) ? 15 - s : s;
                if (i < 2 * REP2F) att::attn_unit<0>(lds, b, h, qb, bufs + 0 * BUF_ELEMS, bufs + 1 * BUF_ELEMS, bufs + 2 * BUF_ELEMS, bufs + 3 * BUF_ELEMS, Y, cum, kmean, gtab);
                else       att::attn_unit<1>(lds, b, h, qb, bufs + 4 * BUF_ELEMS, bufs + 5 * BUF_ELEMS, bufs + 6 * BUF_ELEMS, bufs + 7 * BUF_ELEMS, Y, cum, kmean, gtab);
            }
        }
    }

    GRID_BAR(2);

    if (IN(3)) for (int rep_ = 0; rep_ < REP3; ++rep_) {
        pg8::Gemm g{Y, Wcat_t, M, DM, DM}; pg8::StaticOrder S; S.init(M, DM, G, bx);
        pg8::EpiMerge E{GA, GB, MERGED};
        pg8::gemm_phase<pg8::EpiMerge, pg8::StaticOrder, false>(lds, g, S, E);
    }

    GRID_BAR(3);

    if (IN(4)) for (int rep_ = 0; rep_ < REP4; ++rep_) {
        pg8::Gemm g{MERGED, Wout_t, M, DM, DM}; pg8::StaticOrder S; S.init(M, DM, G, bx);
        pg8::EpiOut E{x, args.out};
        pg8::gemm_phase<pg8::EpiOut, pg8::StaticOrder, false>(lds, g, S, E);
    }
#undef IN
#undef GRID_BAR
}

extern "C" void kernel_launch(void* const* d_in, const int* in_sizes, int n_in, void* d_out, int out_size, void* d_ws, size_t ws_size, hipStream_t stream) {
    static int grid = 0;
    if (grid == 0) {
        if (n_in != 12 || in_sizes[0] != M * DM || out_size != M * DM || ws_size < WS_END) { fprintf(stderr, "kernel_launch: unexpected shapes (n_in %d, in0 %d, out %d, ws %zu)\n", n_in, n_in > 0 ? in_sizes[0] : -1, out_size, ws_size); grid = -1; return; }
        if (hipFuncSetAttribute((const void*)fwd, hipFuncAttributeMaxDynamicSharedMemorySize, LDS_BYTES) != hipSuccess) { fprintf(stderr, "kernel_launch: hipFuncSetAttribute failed\n"); grid = -1; return; }
        int dev = 0, cus = 0, per_cu = 0; (void)hipGetDevice(&dev); (void)hipDeviceGetAttribute(&cus, hipDeviceAttributeMultiprocessorCount, dev);
        if (hipOccupancyMaxActiveBlocksPerMultiprocessor(&per_cu, (const void*)fwd, NWAVES * 64, LDS_BYTES) != hipSuccess || per_cu < 1) { fprintf(stderr, "kernel_launch: occupancy query says %d blocks per CU\n", per_cu); grid = -1; return; }
        grid = cus;
        if (grid != 256) fprintf(stderr, "kernel_launch: %d CUs (built for 256)\n", grid);
    }
    if (grid < 0) return;
    Args a{};
    for (int i = 0; i < 12; ++i) a.in[i] = (const float*)d_in[i];
    a.out = (float*)d_out; a.ws = (unsigned char*)d_ws; a.ph_lo = 0; a.ph_hi = 5;
    if (hipMemsetAsync((char*)d_ws + WS_CTL, 0, CTL_ZERO_BYTES, stream) != hipSuccess) { fprintf(stderr, "kernel_launch: hipMemsetAsync failed\n"); return; }
    hipLaunchKernelGGL(fwd, dim3(grid), dim3(NWAVES * 64), LDS_BYTES, stream, a);
    const hipError_t e = hipPeekAtLastError();
    if (e != hipSuccess) fprintf(stderr, "kernel_launch: launch failed: %s (grid %d)\n", hipGetErrorString(e), grid);
}
```

```cpp
#include <hip/hip_runtime.h>
#include <cstdio>
#include <cstdint>

#define LAS __attribute__((address_space(3)))
typedef _Float16 h16;
typedef _Float16 f16x8 __attribute__((ext_vector_type(8)));
typedef _Float16 f16x2 __attribute__((ext_vector_type(2)));
typedef float f32x2 __attribute__((ext_vector_type(2)));
typedef float f32x4 __attribute__((ext_vector_type(4)));
typedef float f32x16 __attribute__((ext_vector_type(16)));
typedef unsigned u32x4 __attribute__((ext_vector_type(4)));
typedef unsigned u32x2 __attribute__((ext_vector_type(2)));
typedef short s16x4 __attribute__((ext_vector_type(4)));

constexpr int BATCH = 4, SEQ = 4096, DM = 1024, NH = 8, HD = 64, M = BATCH * SEQ;
constexpr int IN_W = 6152, IN_WG = 6144;
constexpr float RMS_EPS = 1e-6f;
constexpr float LOG2E = 1.4426950408889634f;
constexpr float QSCALE = 0.125f * 1.4426950408889634f;
constexpr int NWAVES = 8;

constexpr size_t MiB = 1u << 20;
constexpr size_t WS_CTL = 0, CTL_ZERO_BYTES = 64 * 1024;
constexpr size_t WS_WIN = 2 * MiB;
constexpr size_t WS_WCAT = 14 * MiB;
constexpr size_t WS_WOUT = 16 * MiB;
constexpr size_t WS_ROPE = 18 * MiB;
constexpr size_t WS_LOGF = 19 * MiB;
constexpr size_t WS_CUM = 19 * MiB + 512 * 1024;
constexpr size_t WS_KMEAN = 20 * MiB;
constexpr size_t WS_GTAB = 21 * MiB;
constexpr size_t WS_IRS = 21 * MiB + 256 * 1024;
constexpr size_t WS_XN = 32 * MiB;
constexpr size_t WS_Y = 224 * MiB;
constexpr size_t WS_BUFS = 64 * MiB;
constexpr size_t BUF_ELEMS = (size_t)M * 512;
constexpr size_t WS_MERGED = 64 * MiB;
constexpr size_t WS_GA = 192 * MiB, WS_GB = 208 * MiB;
constexpr size_t WS_END = 256 * MiB;

constexpr int RING_BYTES = 131072;
constexpr int LDS_BYTES = 147456;

__device__ __forceinline__ int lane_fresh() { unsigned z; asm volatile("v_mov_b32 %0, 0" : "=v"(z)); return (int)__builtin_amdgcn_mbcnt_hi(~0u, __builtin_amdgcn_mbcnt_lo(~0u, z)); }

namespace pg8 {
constexpr int BM = 256, BK = 64, HALF = 128, HTB = HALF * BK * 2, STAGE_BYTES = 8 * HTB, NXCD = 8, WGM = 8;
__host__ __device__ __forceinline__ int lds_byte(int r, int c) { const int st = (r >> 4) * 2 + (c >> 5), rr = r & 15, cc = c & 31, ob = rr * 64 + cc * 2; return st * 1024 + (ob ^ (((ob >> 9) & 1) << 5)); }
__host__ __device__ __forceinline__ void stage_rc(int b, int& R, int& C) { const int st = b / 1024, sb = b % 1024, swz = sb ^ (((sb >> 9) & 1) << 5); R = (st >> 1) * 16 + swz / 64; C = (st & 1) * 32 + (swz % 64) / 2; }
__host__ __device__ __forceinline__ int perm32(int rho) { const int n = rho >> 4, i = rho & 15; return 8 * (i >> 2) + 4 * n + (i & 3); }

struct Unit { int pm, pn; };
struct Gemm { const h16* A; const h16* Bt; int M, N, K; };

__device__ __forceinline__ int lane_fresh_() { return lane_fresh(); }
struct StaticOrder {
    int nM, nN, nwg, G, c;
    __host__ __device__ void init(int M_, int N_, int G_, int c_) { nM = M_ / BM; nN = N_ / BM; nwg = nM * nN; G = G_; c = c_; }
    __host__ __device__ bool next(int i, Unit& u) const {
        const long L = (long)i * G + c; if (L >= nwg) return false;
        int wgid = (int)L; { const int q = nwg / NXCD, r = nwg % NXCD, xcd = wgid % NXCD, off = wgid / NXCD; wgid = (xcd < r ? xcd * (q + 1) : r * (q + 1) + (xcd - r) * q) + off; }
        const int nig = WGM * nN, gid = wgid / nig, fm = gid * WGM, gsz = (nM - fm) < WGM ? (nM - fm) : WGM;
        u.pm = fm + ((wgid % nig) % gsz); u.pn = (wgid % nig) / gsz; return true;
    }
};

struct OneTile { int pm, pn; __host__ __device__ bool next(int i, Unit& u) const { if (i != 0) return false; u.pm = pm; u.pn = pn; return true; } };
struct DealtOrder {
    StaticOrder s;
    __host__ __device__ bool next(int i, Unit& u) const { if (!s.next(i, u)) return false; if (u.pn < 16) u.pn = (int)((0xDFCEBA9875643210ull >> (4 * u.pn)) & 15ull); return true; }
};

__device__ __forceinline__ unsigned cvt_pk_f16(float lo, float hi) { f32x2 v = {lo, hi}; f16x2 h = __builtin_convertvector(v, f16x2); return __builtin_bit_cast(unsigned, h); }

template <class Epi, class Sched, bool ALIGN_EPI = false, bool PEEL = false>
__device__ __forceinline__ void gemm_phase(LAS unsigned char* lds, const Gemm g, const Sched& S, const Epi& E) {
    const int tid = threadIdx.x, wid = __builtin_amdgcn_readfirstlane(tid >> 6), lane = tid & 63, wr = wid >> 2, wc = wid & 3, fr = lane & 15, fq = lane >> 4;
    const int K = g.K, nt = K / BK;
    unsigned voffA[2], voffB[2];
#pragma unroll
    for (int i = 0; i < 2; ++i) { int R, C; stage_rc(tid * 16 + i * 8192, R, C); const int Rb = 64 * (R >> 5) + perm32(R & 31);
        voffA[i] = (unsigned)(R * K + C) * 2u; voffB[i] = (unsigned)(Rb * K + C) * 2u; }
    const size_t kstep = (size_t)(BK * 2);
    const size_t hstep = (size_t)HALF * K * 2;
    const size_t bstep = (size_t)32 * K * 2;
    const size_t tstep = 2 * hstep;
    const unsigned ldsw = (unsigned)wid * 1024u;
    const int aoff = lds_byte(wr * 64 + fr, fq * 8), boff = lds_byte(wc * 32 + fr, fq * 8);
#define PG8_SA(b, h) (((b) * 2 + (h)) * HTB)
#define PG8_SB(b, h) ((4 + (b) * 2 + (h)) * HTB)
#define PG8_STAGE(bufoff, gbase, voff) do { _Pragma("unroll") for (int _i = 0; _i < 2; ++_i) \
        __builtin_amdgcn_global_load_lds((const unsigned*)((const char*)(gbase) + (voff)[_i]), (LAS unsigned*)(lds + (bufoff) + ldsw + _i * 8192), 16, 0, 0); } while (0)
#define PG8_LDA(dst, b, h) do { _Pragma("unroll") for (int m = 0; m < 4; ++m) _Pragma("unroll") for (int k = 0; k < 2; ++k) dst[m][k] = *(const LAS f16x8*)(lds + PG8_SA(b, h) + aoff + m * 2048 + k * 1024); } while (0)
#define PG8_LDB(dst, b, h) do { _Pragma("unroll") for (int n = 0; n < 2; ++n) _Pragma("unroll") for (int k = 0; k < 2; ++k) dst[n][k] = *(const LAS f16x8*)(lds + PG8_SB(b, h) + boff + n * 2048 + k * 1024); } while (0)
#define PG8_MMA(ai, bj, At, Bt) do { __builtin_amdgcn_s_setprio(1); _Pragma("unroll") for (int m = 0; m < 4; ++m) _Pragma("unroll") for (int n = 0; n < 2; ++n) _Pragma("unroll") for (int k = 0; k < 2; ++k) \
        acc[ai][bj][m][n] = __builtin_amdgcn_mfma_f32_16x16x32_f16(Bt[n][k], At[m][k], acc[ai][bj][m][n], 0, 0, 0); __builtin_amdgcn_s_setprio(0); } while (0)
#define PG8_WAIT_V(n) asm volatile("s_waitcnt vmcnt(" #n ")" ::: "memory")
#define PG8_WAIT_L(n) asm volatile("s_waitcnt lgkmcnt(" #n ")" ::: "memory")
#define PG8_BAR __builtin_amdgcn_s_barrier()
#define PG8_SCHED __builtin_amdgcn_sched_barrier(0)
    Unit cur, nxt; int ui = 0;
    if (!S.next(0, cur)) return;
    f32x4 acc[2][2][4][2];
#pragma unroll
    for (int a = 0; a < 2; ++a)
#pragma unroll
        for (int b = 0; b < 2; ++b)
#pragma unroll
            for (int m = 0; m < 4; ++m)
#pragma unroll
                for (int n = 0; n < 2; ++n) acc[a][b][m][n] = (f32x4){0.f, 0.f, 0.f, 0.f};
    f16x8 At[4][2], B0[2][2], B1[2][2];
    const char* cA = (const char*)g.A + (size_t)cur.pm * tstep; const char* cB = (const char*)g.Bt + (size_t)cur.pn * tstep;
    PG8_STAGE(PG8_SB(0, 0), cB, voffB); PG8_STAGE(PG8_SB(0, 1), cB + bstep, voffB); PG8_STAGE(PG8_SA(0, 0), cA, voffA); PG8_STAGE(PG8_SA(0, 1), cA + hstep, voffA);
    if (wr == 1) PG8_BAR;
    PG8_WAIT_V(2); PG8_BAR;
    PG8_STAGE(PG8_SB(1, 0), cB + kstep, voffB); PG8_STAGE(PG8_SA(1, 0), cA + kstep, voffA); PG8_STAGE(PG8_SB(1, 1), cB + bstep + kstep, voffB);
    PG8_WAIT_V(6); PG8_BAR;
    for (;;) {
        const bool has_next = S.next(ui + 1, nxt);
        const char* nA = has_next ? (const char*)g.A + (size_t)nxt.pm * tstep : cA; const char* nB = has_next ? (const char*)g.Bt + (size_t)nxt.pn * tstep : cB;
        int t = 0;
        if constexpr (PEEL) if (ui > 0) {
            const bool last = (t == nt - 2);
            if constexpr (Epi::MID) { if (t == nt / 2) E.mid(acc, cur, wr, wc, fr, fq); }
            const char* a1 = cA + (size_t)(t + 1) * kstep;
            const char* a2 = last ? nA : cA + (size_t)(t + 2) * kstep; const char* b2 = last ? nB : cB + (size_t)(t + 2) * kstep;
            const char* a3 = a2 + kstep; const char* b3 = b2 + kstep;
            PG8_LDB(B0, 0, 0); PG8_LDB(B1, 0, 1); PG8_SCHED; PG8_LDA(At, 0, 0); PG8_STAGE(PG8_SA(1, 1), a1 + hstep, voffA);
            PG8_WAIT_L(0); PG8_BAR; PG8_MMA(0, 0, At, B0); PG8_MMA(0, 1, At, B1); PG8_BAR; PG8_SCHED;
            PG8_LDA(At, 0, 1); PG8_STAGE(PG8_SB(0, 0), b2, voffB); PG8_STAGE(PG8_SB(0, 1), b2 + bstep, voffB); PG8_STAGE(PG8_SA(0, 0), a2, voffA);
            PG8_WAIT_L(0); PG8_BAR; PG8_MMA(1, 0, At, B0); PG8_MMA(1, 1, At, B1); PG8_BAR; PG8_SCHED;
            PG8_LDB(B0, 1, 0); PG8_LDB(B1, 1, 1); PG8_SCHED; PG8_LDA(At, 1, 0); PG8_STAGE(PG8_SA(0, 1), a2 + hstep, voffA);
            PG8_WAIT_V(8); PG8_WAIT_L(0); PG8_BAR; PG8_MMA(0, 0, At, B0); PG8_MMA(0, 1, At, B1); PG8_BAR; PG8_SCHED;
            PG8_LDA(At, 1, 1); PG8_STAGE(PG8_SB(1, 0), b3, voffB); PG8_STAGE(PG8_SB(1, 1), b3 + bstep, voffB); PG8_STAGE(PG8_SA(1, 0), a3, voffA);
            PG8_WAIT_V(8); PG8_WAIT_L(0); PG8_BAR; PG8_MMA(1, 0, At, B0); PG8_MMA(1, 1, At, B1); PG8_BAR; PG8_SCHED;
            t = 2;
        }
        for (; t < nt; t += 2) {
            const bool last = (t == nt - 2);
            if constexpr (Epi::MID) { if (t == nt / 2) E.mid(acc, cur, wr, wc, fr, fq); }
            const char* a1 = cA + (size_t)(t + 1) * kstep;
            const char* a2 = last ? nA : cA + (size_t)(t + 2) * kstep; const char* b2 = last ? nB : cB + (size_t)(t + 2) * kstep;
            const char* a3 = a2 + kstep; const char* b3 = b2 + kstep;
            PG8_LDB(B0, 0, 0); PG8_LDB(B1, 0, 1); PG8_SCHED; PG8_LDA(At, 0, 0); PG8_STAGE(PG8_SA(1, 1), a1 + hstep, voffA);
            PG8_WAIT_V(8); PG8_WAIT_L(0); PG8_BAR; PG8_MMA(0, 0, At, B0); PG8_MMA(0, 1, At, B1); PG8_BAR; PG8_SCHED;
            PG8_LDA(At, 0, 1); PG8_STAGE(PG8_SB(0, 0), b2, voffB); PG8_STAGE(PG8_SB(0, 1), b2 + bstep, voffB); PG8_STAGE(PG8_SA(0, 0), a2, voffA);
            PG8_WAIT_V(8); PG8_WAIT_L(0); PG8_BAR; PG8_MMA(1, 0, At, B0); PG8_MMA(1, 1, At, B1); PG8_BAR; PG8_SCHED;
            PG8_LDB(B0, 1, 0); PG8_LDB(B1, 1, 1); PG8_SCHED; PG8_LDA(At, 1, 0); PG8_STAGE(PG8_SA(0, 1), a2 + hstep, voffA);
            PG8_WAIT_V(8); PG8_WAIT_L(0); PG8_BAR; PG8_MMA(0, 0, At, B0); PG8_MMA(0, 1, At, B1); PG8_BAR; PG8_SCHED;
            PG8_LDA(At, 1, 1); PG8_STAGE(PG8_SB(1, 0), b3, voffB); PG8_STAGE(PG8_SB(1, 1), b3 + bstep, voffB); PG8_STAGE(PG8_SA(1, 0), a3, voffA);
            PG8_WAIT_V(8); PG8_WAIT_L(0); PG8_BAR; PG8_MMA(1, 0, At, B0); PG8_MMA(1, 1, At, B1); PG8_BAR; PG8_SCHED;
        }
        if constexpr (ALIGN_EPI) { if (wr == 0) PG8_BAR; }
        if constexpr (PEEL) { if (has_next) PG8_WAIT_V(0); }
        E(acc, cur, wr, wc, fr, fq);
        if (!has_next) break;
#pragma unroll
        for (int a = 0; a < 2; ++a)
#pragma unroll
            for (int b = 0; b < 2; ++b)
#pragma unroll
                for (int m = 0; m < 4; ++m)
#pragma unroll
                    for (int n = 0; n < 2; ++n) acc[a][b][m][n] = (f32x4){0.f, 0.f, 0.f, 0.f};
        cur = nxt; cA = nA; cB = nB; ++ui;
        if constexpr (ALIGN_EPI) { if (wr == 1) PG8_BAR; }
    }
    PG8_WAIT_V(0);
    if constexpr (!ALIGN_EPI) { if (wr == 0) PG8_BAR; }
    PG8_BAR;
#undef PG8_SA
#undef PG8_SB
#undef PG8_STAGE
#undef PG8_LDA
#undef PG8_LDB
#undef PG8_MMA
#undef PG8_WAIT_V
#undef PG8_WAIT_L
#undef PG8_BAR
#undef PG8_SCHED
}

__device__ __forceinline__ float sigmoidf_(float v) { return __builtin_amdgcn_rcpf(1.0f + __builtin_amdgcn_exp2f(-v * LOG2E)); }

struct EpiInProj {
    static constexpr bool MID = false;
    h16* bufs; h16* ga; h16* gb; const float* gtab; const float* bgate; const float* rope; float* kmean;
    __device__ __forceinline__ void operator()(f32x4 (&acc)[2][2][4][2], const Unit& u, int wr, int wc, int fr, int fq) const {
        const int l_ = lane_fresh(); fr = l_ & 15; fq = l_ >> 4;
        const int pn = u.pn;
        if (pn >= 16) {
            const int which = pn >= 20; unsigned char* g = (unsigned char*)(which ? gb : ga);
            const int pnl = pn - (which ? 20 : 16), colbase = pnl * 256 + 64 * wc + 8 * fq;
            f32x4 bv[2][2];
#pragma unroll
            for (int bj = 0; bj < 2; ++bj)
#pragma unroll
                for (int n = 0; n < 2; ++n) bv[bj][n] = *(const f32x4*)(bgate + which * 1024 + colbase + 32 * bj + 4 * n) * (-LOG2E) - 7.994353436858858f;
            const float qfloor = which ? 1.0f : 0.0f;
#pragma unroll
            for (int ai = 0; ai < 2; ++ai)
#pragma unroll
                for (int m = 0; m < 4; ++m) { const size_t row = (size_t)u.pm * 256 + 128 * ai + 64 * wr + 16 * m + fr; u32x4 w;
#pragma unroll
                    for (int bj = 0; bj < 2; ++bj)
#pragma unroll
                        for (int n = 0; n < 2; ++n) { unsigned pk = 0u;
#pragma unroll
                            for (int e = 0; e < 4; ++e) { const float ex = __builtin_amdgcn_exp2f(__builtin_fmaf(acc[ai][bj][m][n][e], -LOG2E, bv[bj][n][e]));
                                const float q = fmaxf(__builtin_amdgcn_rcpf(ex + 1.0f / 255.0f), qfloor); pk = __builtin_amdgcn_cvt_pk_u8_f32(q, e, pk); }
                            w[2 * bj + n] = pk; }
                    *(u32x4*)(g + row * 1024 + pnl * 256 + 64 * wc + 16 * fq) = w; __builtin_amdgcn_sched_barrier(0); }
            return;
        }
        const int grp = pn >> 1, head = 4 * (pn & 1) + wc, b = u.pm >> 4, blk = u.pm & 15;
        const bool do_norm = (grp == 0) | (grp == 1) | (grp == 4) | (grp == 5), do_rope = (grp == 4) | (grp == 5), do_silu = (grp == 3) | (grp == 7), do_kmean = (grp == 5);
        h16* dst = bufs + (size_t)grp * BUF_ELEMS + ((size_t)(b * NH + head) * SEQ) * HD + 8 * fq;
        const int tbase = blk * 256 + 64 * wr + fr;
        f32x4 gs[2][2];
        if (do_norm) { const float* gp = gtab + 64 * ((grp & 1) + ((grp >> 2) << 1));
#pragma unroll
            for (int bj = 0; bj < 2; ++bj)
#pragma unroll
                for (int n = 0; n < 2; ++n) gs[bj][n] = *(const f32x4*)(gp + 32 * bj + 8 * fq + 4 * n); }
        f32x4 cs[2][2];
#pragma unroll
        for (int bj = 0; bj < 2; ++bj)
#pragma unroll
            for (int n = 0; n < 2; ++n) cs[bj][n] = (f32x4){0.f, 0.f, 0.f, 0.f};
#pragma unroll
        for (int ai = 0; ai < 2; ++ai)
#pragma unroll
            for (int m = 0; m < 4; ++m) {
                const int t = tbase + 128 * ai + 16 * m;
                f32x4 v[2][2];
#pragma unroll
                for (int bj = 0; bj < 2; ++bj)
#pragma unroll
                    for (int n = 0; n < 2; ++n) v[bj][n] = acc[ai][bj][m][n];
                if (do_norm) {
                    float ss = 0.f;
#pragma unroll
                    for (int bj = 0; bj < 2; ++bj)
#pragma unroll
                        for (int n = 0; n < 2; ++n) { const f32x4 x = v[bj][n]; ss += (x[0] * x[0] + x[1] * x[1]) + (x[2] * x[2] + x[3] * x[3]); }
                    { auto p16 = __builtin_amdgcn_permlane16_swap(__float_as_uint(ss), __float_as_uint(ss), false, false); ss = __uint_as_float(p16[0]) + __uint_as_float(p16[1]);
                      auto p32 = __builtin_amdgcn_permlane32_swap(__float_as_uint(ss), __float_as_uint(ss), false, false); ss = __uint_as_float(p32[0]) + __uint_as_float(p32[1]); }
                    const float rstd = __builtin_amdgcn_rsqf(ss + 64.0f * RMS_EPS);
#pragma unroll
                    for (int bj = 0; bj < 2; ++bj)
#pragma unroll
                        for (int n = 0; n < 2; ++n) v[bj][n] = v[bj][n] * rstd * gs[bj][n];
                }
                if (do_rope) {
                    f32x4 pr[2];
#pragma unroll
                    for (int n = 0; n < 2; ++n)
#pragma unroll
                        for (int e = 0; e < 4; ++e) pr[n][e] = __int_as_float(__builtin_amdgcn_ds_bpermute((l_ ^ 16) << 2, __float_as_int(v[0][n][e])));
                    if (fq < 2) {
#pragma unroll
                        for (int n = 0; n < 2; ++n) { const f32x4 c = *(const f32x4*)(rope + t * 8 + 4 * n), s = *(const f32x4*)(rope + SEQ * 8 + t * 8 + 4 * n);
                            v[0][n] = (fq == 0) ? (v[0][n] * c - pr[n] * s) : (v[0][n] * c + pr[n] * s); }
                    }
                }
                if (do_kmean) {
#pragma unroll
                    for (int bj = 0; bj < 2; ++bj)
#pragma unroll
                        for (int n = 0; n < 2; ++n) cs[bj][n] += v[bj][n];
                }
                if (do_silu) {
#pragma unroll
                    for (int bj = 0; bj < 2; ++bj)
#pragma unroll
                        for (int n = 0; n < 2; ++n)
#pragma unroll
                            for (int e = 0; e < 4; ++e) v[bj][n][e] = v[bj][n][e] * __builtin_amdgcn_rcpf(1.0f + __builtin_amdgcn_exp2f(v[bj][n][e]));
                }
#pragma unroll
                for (int bj = 0; bj < 2; ++bj) { u32x4 w; w.x = cvt_pk_f16(v[bj][0][0], v[bj][0][1]); w.y = cvt_pk_f16(v[bj][0][2], v[bj][0][3]); w.z = cvt_pk_f16(v[bj][1][0], v[bj][1][1]); w.w = cvt_pk_f16(v[bj][1][2], v[bj][1][3]);
                    *(u32x4*)(dst + (size_t)t * HD + 32 * bj) = w; }
            }
        if (do_kmean) {
#pragma unroll
            for (int bj = 0; bj < 2; ++bj)
#pragma unroll
                for (int n = 0; n < 2; ++n)
#pragma unroll
                    for (int e = 0; e < 4; ++e) { float s = cs[bj][n][e];
#define DPPF_(x, ctrl) __int_as_float(__builtin_amdgcn_update_dpp(0, __float_as_int(x), ctrl, 0xF, 0xF, true))
                        s += DPPF_(s, 0xB1); s += DPPF_(s, 0x4E); s += DPPF_(s, 0x141); s += DPPF_(s, 0x140);
#undef DPPF_
                        if (fr == 0) atomicAdd(kmean + ((size_t)(b * NH + head) * 16 + blk) * HD + 32 * bj + 8 * fq + 4 * n + e, s * (1.0f / 256.0f)); }
        }
    }
};

struct EpiMerge {
    static constexpr bool MID = true;
    const unsigned char* __restrict__ ga; const unsigned char* __restrict__ gb; h16* __restrict__ out;
#define GATE_B(w, bj, n, e) ((float)(((w)[2 * (bj) + (n)] >> (8 * (e))) & 255u))
    __device__ __forceinline__ void mid(f32x4 (&acc)[2][2][4][2], const Unit& u, int wr, int wc, int fr, int fq) const {
        { const int l_ = lane_fresh(); fr = l_ & 15; fq = l_ >> 4; }
        const int col0 = u.pn * 256 + 64 * wc + 16 * fq;
#pragma unroll
        for (int ai = 0; ai < 2; ++ai) {
            u32x4 a[4], bb[4];
#pragma unroll
            for (int m = 0; m < 4; ++m) { const size_t row = (size_t)u.pm * 256 + 128 * ai + 64 * wr + 16 * m + fr;
                a[m] = *(const u32x4*)(ga + row * 1024 + col0); bb[m] = *(const u32x4*)(gb + row * 1024 + col0); }
            asm volatile("" ::: "memory");
#pragma unroll
            for (int m = 0; m < 4; ++m)
#pragma unroll
                for (int bj = 0; bj < 2; ++bj)
#pragma unroll
                    for (int n = 0; n < 2; ++n)
#pragma unroll
                        for (int e = 0; e < 4; ++e) acc[ai][bj][m][n][e] *= GATE_B(a[m], bj, n, e) * __builtin_amdgcn_rcpf(GATE_B(bb[m], bj, n, e));
            asm volatile("" ::: "memory"); }
    }
    __device__ __forceinline__ void operator()(f32x4 (&acc)[2][2][4][2], const Unit& u, int wr, int wc, int fr, int fq) const {
        { const int l_ = lane_fresh(); fr = l_ & 15; fq = l_ >> 4; }
        const int col0 = u.pn * 256 + 64 * wc;
        u32x4 bb[2][4];
#pragma unroll
        for (int ai = 0; ai < 2; ++ai)
#pragma unroll
            for (int m = 0; m < 4; ++m) { const size_t row = (size_t)u.pm * 256 + 128 * ai + 64 * wr + 16 * m + fr; bb[ai][m] = *(const u32x4*)(gb + row * 1024 + col0 + 16 * fq); }
        asm volatile("" ::: "memory");
        const float sc = 1.0f / 255.0f;
#pragma unroll
        for (int ai = 0; ai < 2; ++ai)
#pragma unroll
            for (int m = 0; m < 4; ++m) { const size_t row = (size_t)u.pm * 256 + 128 * ai + 64 * wr + 16 * m + fr;
#pragma unroll
                for (int bj = 0; bj < 2; ++bj) { const f32x4 v0 = acc[ai][bj][m][0] * sc, v1 = acc[ai][bj][m][1] * sc; u32x4 w;
                    w.x = cvt_pk_f16(v0[0] * GATE_B(bb[ai][m], bj, 0, 0), v0[1] * GATE_B(bb[ai][m], bj, 0, 1)); w.y = cvt_pk_f16(v0[2] * GATE_B(bb[ai][m], bj, 0, 2), v0[3] * GATE_B(bb[ai][m], bj, 0, 3));
                    w.z = cvt_pk_f16(v1[0] * GATE_B(bb[ai][m], bj, 1, 0), v1[1] * GATE_B(bb[ai][m], bj, 1, 1)); w.w = cvt_pk_f16(v1[2] * GATE_B(bb[ai][m], bj, 1, 2), v1[3] * GATE_B(bb[ai][m], bj, 1, 3));
                    *(u32x4*)(out + row * 1024 + col0 + 8 * fq + 32 * bj) = w; } }
    }
#undef GATE_B
};

struct EpiOut {
    static constexpr bool MID = false;
    const float* __restrict__ x; float* __restrict__ out; const h16* __restrict__ xn; const float* __restrict__ irs; const float* __restrict__ ng;
    __device__ __forceinline__ void operator()(f32x4 (&acc)[2][2][4][2], const Unit& u, int wr, int wc, int fr, int fq) const {
        { const int l_ = lane_fresh(); fr = l_ & 15; fq = l_ >> 4; }
        const int col0 = u.pn * 256 + 64 * wc + 8 * fq;
        f32x4 ig[2][2]; bool bad = false;
#pragma unroll
        for (int bj = 0; bj < 2; ++bj)
#pragma unroll
            for (int n = 0; n < 2; ++n) { const f32x4 g = *(const f32x4*)(ng + col0 + 32 * bj + 4 * n);
#pragma unroll
                for (int e = 0; e < 4; ++e) { bad |= !(fabsf(g[e]) >= 0.00390625f); ig[bj][n][e] = __builtin_amdgcn_rcpf(g[e]); } }
        if (!__any(bad)) {
            u32x4 xh[2][4][2]; float rs[2][4];
#pragma unroll
            for (int ai = 0; ai < 2; ++ai)
#pragma unroll
                for (int m = 0; m < 4; ++m) { const size_t row = (size_t)u.pm * 256 + 128 * ai + 64 * wr + 16 * m + fr; rs[ai][m] = irs[row];
#pragma unroll
                    for (int bj = 0; bj < 2; ++bj) xh[ai][m][bj] = *(const u32x4*)(xn + row * 1024 + col0 + 32 * bj); }
            asm volatile("" ::: "memory");
#pragma unroll
            for (int ai = 0; ai < 2; ++ai)
#pragma unroll
                for (int m = 0; m < 4; ++m) { const size_t off = ((size_t)u.pm * 256 + 128 * ai + 64 * wr + 16 * m + fr) * 1024 + col0;
#pragma unroll
                    for (int bj = 0; bj < 2; ++bj) { const f16x8 hv = __builtin_bit_cast(f16x8, xh[ai][m][bj]);
#pragma unroll
                        for (int n = 0; n < 2; ++n) { f32x4 o;
#pragma unroll
                            for (int e = 0; e < 4; ++e) o[e] = __builtin_fmaf((float)hv[4 * n + e], rs[ai][m] * ig[bj][n][e], acc[ai][bj][m][n][e]);
                            *(f32x4*)(out + off + 32 * bj + 4 * n) = o; } } }
            asm volatile("" ::: "memory");
            return;
        }
#pragma unroll
        for (int ai = 0; ai < 2; ++ai) {
            f32x4 xv[4][2][2];
#pragma unroll
            for (int m = 0; m < 4; ++m) { const size_t off = ((size_t)u.pm * 256 + 128 * ai + 64 * wr + 16 * m + fr) * 1024 + col0;
#pragma unroll
                for (int bj = 0; bj < 2; ++bj)
#pragma unroll
                    for (int n = 0; n < 2; ++n) xv[m][bj][n] = *(const f32x4*)(x + off + 32 * bj + 4 * n); }
            asm volatile("" ::: "memory");
#pragma unroll
            for (int m = 0; m < 4; ++m) { const size_t off = ((size_t)u.pm * 256 + 128 * ai + 64 * wr + 16 * m + fr) * 1024 + col0;
#pragma unroll
                for (int bj = 0; bj < 2; ++bj)
#pragma unroll
                    for (int n = 0; n < 2; ++n) *(f32x4*)(out + off + 32 * bj + 4 * n) = xv[m][bj][n] + acc[ai][bj][m][n]; }
            asm volatile("" ::: "memory");
        }
    }
};
}

namespace fa {
constexpr int NW = 8, QBLK = 32, QB = 256, KVBLK = 64, PT = 64;
__device__ __forceinline__ int crow(int r, int hi) { return (r & 3) + 8 * (r >> 2) + 4 * hi; }
#define SBAR() __builtin_amdgcn_sched_barrier(0)
__device__ __forceinline__ void cmask(f32x16& p0, f32x16& p1, int jb, int qrel, int hi) {
    const float NEG = -INFINITY; int kb = 64 * jb + 4 * hi;
#pragma unroll
    for (int r = 0; r < 16; ++r) { int kv = kb + (r & 3) + 8 * (r >> 2); if (kv > qrel) p0[r] = NEG; if (kv + 32 > qrel) p1[r] = NEG; }
}
constexpr int NSLOT = 3, SLOTB = 8192;
constexpr int LDS_K = 0, LDS_V = NSLOT * SLOTB, LDS_WS = 2 * NSLOT * SLOTB, LDS_OST = LDS_WS + NW * 256 * 4, LDS_SEL = LDS_OST + NW * 4096, LDS_KM = LDS_SEL + 1024, LDS_END = LDS_KM + 4096;
__device__ __forceinline__ void glds16(const void* gsrc, unsigned lds_dst) { unsigned keep;
    asm volatile("s_mov_b32 %0, m0\n\ts_mov_b32 m0, %2\n\ts_nop 0\n\tglobal_load_lds_dwordx4 %1, off\n\ts_mov_b32 m0, %0" : "=&s"(keep) : "v"(gsrc), "s"(lds_dst) : "memory"); }
__device__ __forceinline__ void glds4(const void* gsrc, unsigned lds_dst) { unsigned keep;
    asm volatile("s_mov_b32 %0, m0\n\ts_mov_b32 m0, %2\n\ts_nop 0\n\tglobal_load_lds_dword %1, off\n\ts_mov_b32 m0, %0" : "=&s"(keep) : "v"(gsrc), "s"(lds_dst) : "memory"); }
__device__ __forceinline__ float max3f(float a, float b, float c) { float r; asm("v_max3_f32 %0, %1, %2, %3" : "=v"(r) : "v"(a), "v"(b), "v"(c)); return r; }
__device__ __forceinline__ float max2f(float a, float b) { float r; asm("v_max_f32_e32 %0, %1, %2" : "=v"(r) : "v"(a), "v"(b)); return r; }
__device__ __forceinline__ float fsub_s(float a, float b) { float r; asm("v_sub_f32_e32 %0, %1, %2" : "=v"(r) : "v"(a), "v"(b)); return r; }
__device__ __forceinline__ unsigned cvtpk_s(float lo, float hi) { f32x2 v = {lo, hi}; f16x2 b = __builtin_convertvector(v, f16x2); return __builtin_bit_cast(unsigned, b); }
#define WAIT_BAR(N) asm volatile("s_waitcnt vmcnt(" #N ") lgkmcnt(0)\n\ts_barrier" ::: "memory")
#define MFMA32(a, b, c) __builtin_amdgcn_mfma_f32_32x32x16_f16(a, b, c, 0, 0, 0)
typedef LAS const unsigned char* lds_cptr;
typedef short v4i16_t __attribute__((ext_vector_type(4)));
__device__ __forceinline__ void qkt(f32x16& p0, f32x16& p1, lds_cptr Kslot, const f16x8* qr, const f32x16& c0, const f32x16& c1, int r32, int hi) {
    lds_cptr kb = Kslot + hi * 1024 + r32 * 16;
#pragma unroll
    for (int d0 = 0; d0 < 4; ++d0) {
        const f16x8 b0 = *(const LAS f16x8*)(kb + d0 * 2048), b1 = *(const LAS f16x8*)(kb + d0 * 2048 + 512);
        if (d0 == 0) { p0 = MFMA32(b0, qr[0], c0); p1 = MFMA32(b1, qr[0], c1); }
        else { p0 = MFMA32(b0, qr[d0], p0); p1 = MFMA32(b1, qr[d0], p1); } }
}
__device__ __forceinline__ void kload8(f16x8* kf, lds_cptr kp) {
    kf[0] = *(const LAS f16x8*)(kp);        kf[1] = *(const LAS f16x8*)(kp + 512);
    kf[2] = *(const LAS f16x8*)(kp + 2048); kf[3] = *(const LAS f16x8*)(kp + 2560);
    kf[4] = *(const LAS f16x8*)(kp + 4096); kf[5] = *(const LAS f16x8*)(kp + 4608);
    kf[6] = *(const LAS f16x8*)(kp + 6144); kf[7] = *(const LAS f16x8*)(kp + 6656);
}
__device__ __forceinline__ void kload2(f16x8* kf, lds_cptr kp, int j) { kf[2 * j] = *(const LAS f16x8*)(kp + j * 2048); kf[2 * j + 1] = *(const LAS f16x8*)(kp + j * 2048 + 512); }
__device__ __forceinline__ s16x4 vtr(lds_cptr p) { return __builtin_bit_cast(s16x4, __builtin_amdgcn_ds_read_tr16_b64_v4i16((LAS v4i16_t*)p)); }
__device__ __forceinline__ float rowmax(const f32x16& p0, const f32x16& p1) {
    float a = max3f(p0[0], p0[1], p1[0]), b = max3f(p0[2], p0[3], p1[1]); a = max3f(a, p1[2], p1[3]);
#pragma unroll
    for (int r = 4; r < 16; r += 4) { a = max3f(a, p0[r], p0[r + 1]); b = max3f(b, p0[r + 2], p0[r + 3]); a = max3f(a, p1[r], p1[r + 1]); b = max3f(b, p1[r + 2], p1[r + 3]); }
    const float m = max2f(a, b);
    auto rr = __builtin_amdgcn_permlane32_swap(__float_as_uint(m), __float_as_uint(m), false, false);
    return max2f(__uint_as_float(rr[0]), __uint_as_float(rr[1]));
}
typedef short s16x8 __attribute__((ext_vector_type(8)));
#define F8(lo, hh) __builtin_bit_cast(f16x8, (s16x8){lo[0], lo[1], lo[2], lo[3], hh[0], hh[1], hh[2], hh[3]})
__device__ __forceinline__ void pv(f32x16* o, unsigned vb, f16x8 pa0, f16x8 pa1, f16x8 pa2, f16x8 pa3) {
#pragma unroll
    for (int d0 = 0; d0 < 2; ++d0) { s16x4 lo[4], hh[4];
#pragma unroll
        for (int ks = 0; ks < 4; ++ks) {
            asm volatile("ds_read_b64_tr_b16 %0,%1 offset:%c2" : "=&v"(lo[ks]) : "v"(vb), "i"(d0 * 4096 + ks * 1024) : "memory");
            asm volatile("ds_read_b64_tr_b16 %0,%1 offset:%c2" : "=&v"(hh[ks]) : "v"(vb), "i"(d0 * 4096 + ks * 1024 + 512) : "memory"); }
        asm volatile("s_waitcnt lgkmcnt(0)" ::: "memory"); SBAR();
        o[d0] = MFMA32(pa0, F8(lo[0], hh[0]), o[d0]);
        o[d0] = MFMA32(pa1, F8(lo[1], hh[1]), o[d0]);
        o[d0] = MFMA32(pa2, F8(lo[2], hh[2]), o[d0]);
        o[d0] = MFMA32(pa3, F8(lo[3], hh[3]), o[d0]);
    }
}

template <int TYPE, int THRL, bool FIXED>
__device__ __forceinline__ int attn_unit(LAS unsigned char* shm, int b, int h, int qb, const h16* Q, const h16* __restrict__ K, const h16* __restrict__ V, const h16* __restrict__ Zs, h16* Y,
                                         const float* __restrict__ cb2h, float cref2, int jstart, const float* __restrict__ kmeanh, float floor2,
                                         int rot0, const h16* nKt, const h16* nVt, const float* ncb1, int ntype) {
    int tid = threadIdx.x; asm volatile("" : "+v"(tid));
    const int lane = tid & 63, r32 = lane & 31, hi = lane >> 5; const int wid = __builtin_amdgcn_readfirstlane(tid >> 6);
    const size_t headoff = (size_t)(b * NH + h) * SEQ * HD; const int q0 = qb * QB;
    const h16* Qw = Q + headoff + (size_t)(q0 + wid * QBLK) * PT;
    const h16* Kh = K + headoff + (size_t)jstart * KVBLK * PT; const h16* Vh = V + headoff + (size_t)jstart * KVBLK * PT;
    const float* cbt = cb2h + jstart * KVBLK;
    const unsigned lds0 = (unsigned)(size_t)shm;
    LAS float* wsf = (LAS float*)(shm + LDS_WS) + wid * 256;
    unsigned selm = 0u;
    const h16* ksrc = Kh + (size_t)lane * PT + wid * 8;
    const h16* vsrc = Vh + (size_t)(16 * (wid & 3) + (lane >> 2)) * PT + (wid >> 2) * 32 + (lane & 3) * 8;
    const unsigned kdst = lds0 + LDS_K + wid * 1024, vdst = lds0 + LDS_V + wid * 1024;
#define DMA_K(t, slot) glds16(ksrc + (size_t)(t) * KVBLK * PT, (unsigned)__builtin_amdgcn_readfirstlane(kdst + (slot)))
#define DMA_V(t, slot) glds16(vsrc + (size_t)(t) * KVBLK * PT, (unsigned)__builtin_amdgcn_readfirstlane(vdst + (slot)))
#define DMA_B(t, line) glds4(cbt + (size_t)(t) * KVBLK + lane, (unsigned)__builtin_amdgcn_readfirstlane(lds0 + LDS_WS + wid * 1024 + 256 + (line) * 256))
    const unsigned vb0 = lds0 + LDS_V + ((lane >> 4) & 1) * 32 + (lane & 3) * 8 + (4 * hi + ((lane & 15) >> 2)) * 64;
    f16x8 kf[8];
    const lds_cptr kp0 = shm + LDS_K + hi * 1024 + r32 * 16; const lds_cptr vp0 = shm + LDS_V + ((lane >> 4) & 1) * 32 + (lane & 3) * 8 + (4 * hi + ((lane & 15) >> 2)) * 64;
    const int NT = (q0 + QB) / KVBLK - jstart;
#define NXTS(x) (((x) == (NSLOT - 1) * SLOTB) ? 0 : (x) + SLOTB)
    const int s0 = (rot0 < 0 ? 0 : rot0) * SLOTB, s1 = NXTS(s0), s2 = NXTS(s1);
    if (rot0 < 0) { DMA_K(0, s0); DMA_V(0, s0); DMA_K(1, s1); if (TYPE == 0) DMA_B(1, 1); }
    f16x8 qr[4];
#pragma unroll
    for (int d0 = 0; d0 < 4; ++d0) qr[d0] = *(const f16x8*)(Qw + (size_t)r32 * PT + d0 * 16 + hi * 8);
    if (TYPE == 1) {
        if (qb <= 3) selm = (2u << qb) - 1u;
        else {
            f32x16 gt = f32x16{};
#pragma unroll
            for (int d0 = 0; d0 < 4; ++d0) { const float* kp = kmeanh + (r32 & 15) * HD + 16 * d0 + 8 * hi; const f32x4 ka = *(const f32x4*)kp, kb = *(const f32x4*)(kp + 4);
                f16x8 kh, kl;
#pragma unroll
                for (int e = 0; e < 4; ++e) { const float va = (r32 < 16) ? ka[e] : 0.f, vb = (r32 < 16) ? kb[e] : 0.f; kh[e] = (h16)va; kh[4 + e] = (h16)vb; kl[e] = (h16)(va - (float)kh[e]); kl[4 + e] = (h16)(vb - (float)kh[4 + e]); }
                gt = MFMA32(kh, qr[d0], gt); gt = MFMA32(kl, qr[d0], gt); }
            float b0 = -INFINITY, b1 = -INFINITY, b2 = -INFINITY; int i0 = 0, i1 = 0, i2 = 0;
#pragma unroll
            for (int r = 0; r < 8; ++r) { const int n = (r & 3) + 8 * (r >> 2) + 4 * hi; const float gsum = (n < qb) ? gt[r] : -INFINITY;
                if (gsum > b0) { b2 = b1; i2 = i1; b1 = b0; i1 = i0; b0 = gsum; i0 = n; }
                else if (gsum > b1) { b2 = b1; i2 = i1; b1 = gsum; i1 = n; }
                else if (gsum > b2) { b2 = gsum; i2 = n; } }
            float c[6]; int ci[6];
            { auto r0 = __builtin_amdgcn_permlane32_swap(__float_as_uint(b0), __float_as_uint(b0), false, false); c[0] = __uint_as_float(r0[0]); c[3] = __uint_as_float(r0[1]);
              auto r1 = __builtin_amdgcn_permlane32_swap(__float_as_uint(b1), __float_as_uint(b1), false, false); c[1] = __uint_as_float(r1[0]); c[4] = __uint_as_float(r1[1]);
              auto r2 = __builtin_amdgcn_permlane32_swap(__float_as_uint(b2), __float_as_uint(b2), false, false); c[2] = __uint_as_float(r2[0]); c[5] = __uint_as_float(r2[1]);
              auto j0 = __builtin_amdgcn_permlane32_swap((unsigned)i0, (unsigned)i0, false, false); ci[0] = (int)j0[0]; ci[3] = (int)j0[1];
              auto j1 = __builtin_amdgcn_permlane32_swap((unsigned)i1, (unsigned)i1, false, false); ci[1] = (int)j1[0]; ci[4] = (int)j1[1];
              auto j2 = __builtin_amdgcn_permlane32_swap((unsigned)i2, (unsigned)i2, false, false); ci[2] = (int)j2[0]; ci[5] = (int)j2[1]; }
            float m0 = -INFINITY, m1 = -INFINITY, m2 = -INFINITY; int k0 = 0, k1 = 0, k2 = 0;
#pragma unroll
            for (int q = 0; q < 6; ++q) { const float gsum = c[q]; const int n = ci[q];
                if (gsum > m0 || (gsum == m0 && n < k0)) { m2 = m1; k2 = k1; m1 = m0; k1 = k0; m0 = gsum; k0 = n; }
                else if (gsum > m1 || (gsum == m1 && n < k1)) { m2 = m1; k2 = k1; m1 = gsum; k1 = n; }
                else if (gsum > m2 || (gsum == m2 && n < k2)) { m2 = gsum; k2 = n; } }
            selm = (1u << k0) | (1u << k1) | (1u << k2) | (1u << qb);
        }
    }
    float mhat = 0.f, l_reg = 0.f; f32x16 o[2]; o[0] = f32x16{}; o[1] = f32x16{};
    float nm = 0.f;
    f32x16 negm = f32x16{}; asm volatile("" : "+v"(negm));
#define NEGM_SET() do { _Pragma("unroll") for (int r = 0; r < 16; ++r) negm[r] = nm; asm volatile("" : "+v"(negm)); } while (0)
    float cm = 0.f;
    const int qrel = wid * QBLK + r32;
    f32x16 pA0, pA1, pB0, pB1;
    if (TYPE == 0) {
#pragma unroll
        for (int g4 = 0; g4 < 4; ++g4) { const f32x4 c0 = *(const f32x4*)(cbt + 8 * g4 + 4 * hi), c1 = *(const f32x4*)(cbt + 32 + 8 * g4 + 4 * hi);
#pragma unroll
            for (int e = 0; e < 4; ++e) { pA0[4 * g4 + e] = c0[e] + cref2; pA1[4 * g4 + e] = c1[e] + cref2; } }
    }
#define CMASK(P0, P1, t) do { int jb_ = (t) - (NT - 4); if (jb_ >= 0) cmask(P0, P1, jb_, qrel, hi); } while (0)
    bool resc = false;
    bool cur_sel = true;
    if (TYPE == 1) { cur_sel = (selm & 1u) != 0u; nm = cur_sel ? 0.f : -INFINITY;
#pragma unroll
        for (int r = 0; r < 16; ++r) { pA0[r] = nm; pA1[r] = nm; } }
#define RESC() do { if (resc) { asm volatile("s_waitcnt lgkmcnt(0)" ::: "memory"); \
      _Pragma("unroll") for (int d_ = 0; d_ < 2; ++d_) _Pragma("unroll") for (int r = 0; r < 16; ++r) o[d_][r] *= wsf[crow(r, hi)]; } } while (0)
    int sl_prev = s0, sl_cur = s0, sl_next = s1;
#define ROT() do { sl_prev = sl_cur; sl_cur = sl_next; sl_next = (sl_next == (NSLOT - 1) * SLOTB) ? 0 : sl_next + SLOTB; } while (0)
    if (rot0 < 0) DMA_K(2, s2);
    WAIT_BAR(3);
    qkt(pA0, pA1, shm + LDS_K + s0, qr, pA0, pA1, r32, hi);
    asm volatile("s_nop 15\n\ts_nop 7" : "+v"(pA0), "+v"(pA1)); CMASK(pA0, pA1, 0);
    { resc = false;
      const float dl = FIXED ? (-floor2 - 15.0f) : (TYPE == 0) ? (cref2 + cbt[(q0 - jstart * KVBLK) + wid * QBLK + r32]) : fmaxf(rowmax(pA0, pA1), floor2); mhat = dl;
#pragma unroll
      for (int r = 0; r < 16; ++r) { pA0[r] = fsub_s(pA0[r], dl); pA1[r] = fsub_s(pA1[r], dl); }
      if (TYPE == 0) cm = cref2 - mhat;
      else { nm = cur_sel ? -mhat : -INFINITY; NEGM_SET(); }
#pragma unroll
      for (int r = 0; r < 16; ++r) pA0[r] = __builtin_amdgcn_exp2f(pA0[r]); }
#pragma unroll
    for (int r = 0; r < 16; ++r) pA1[r] = __builtin_amdgcn_exp2f(pA1[r]);
    WAIT_BAR(0);
    DMA_K(3, s0); DMA_V(1, s1);
    ROT();
    kload8(kf, kp0 + sl_cur);
    WAIT_BAR(2);
    s16x4 vlo[8], vhi[8]; u32x4 pw0, pw1, pw2, pw3;
#define PKW(P, B) cvtpk_s(P[B], P[B + 1])
#define PAF(k) __builtin_bit_cast(f16x8, pw##k)
#define VFR(i) F8(vlo[i], vhi[i])
#define PIN(x) asm volatile("" : "+v"(x))
#define MX3(a, b, c) __builtin_fmaxf(__builtin_fmaxf((a), (b)), (c))
#define GAPA(MF, A0, A1, A2, A3, W0, W1, PW) do { MF; sacc += A0; sacc += A1; sacc += A2; sacc += A3; PIN(sacc); W0; W1; PIN(PW); SBAR(); } while (0)
#define EX(v) __builtin_amdgcn_exp2f(v)
#define GAPB(MF, X, B) do { MF; X[B] = EX(X[B]); X[B + 1] = EX(X[B + 1]); X[B + 2] = EX(X[B + 2]); X[B + 3] = EX(X[B + 3]); PIN(X); SBAR(); } while (0)
#define VRD(i) do { vlo[i] = vtr(vp_ + (((i) >> 2) * 4096 + ((i) & 3) * 1024)); vhi[i] = vtr(vp_ + (((i) >> 2) * 4096 + ((i) & 3) * 1024 + 512)); } while (0)
#define KRD(G, j) do { if (G) { kload2(kf, kp0 + sl_next, j); SBAR(); } } while (0)
#define CINIT(C0, C1, t, GB, LN) do { \
    if (TYPE == 0) { \
        _Pragma("unroll") for (int g4 = 0; g4 < 4; ++g4) { const f32x4 c0_ = *(const LAS f32x4*)(wsf + 64 + (LN) * 64 + 8 * g4 + 4 * hi), c1_ = *(const LAS f32x4*)(wsf + 96 + (LN) * 64 + 8 * g4 + 4 * hi); \
            _Pragma("unroll") for (int e = 0; e < 4; ++e) { C0[4 * g4 + e] = c0_[e] + cm; C1[4 * g4 + e] = c1_[e] + cm; } } \
        if (GB) { DMA_B((t) + 1, 1 - (LN)); } \
    } else { \
        if ((((t) + jstart) & 3) == 0) { const int jb2_ = ((t) + jstart) >> 2; cur_sel = ((selm >> jb2_) & 1u) != 0u; nm = cur_sel ? -mhat : -INFINITY; NEGM_SET(); } \
    } } while (0)
#define STEP(C0, C1, P0, P1, t, GK, GV, GL, LN) do { SBAR(); \
    CINIT(C0, C1, t, GL, LN); SBAR(); \
    const lds_cptr vp_ = vp0 + sl_prev; \
    VRD(0); SBAR(); float sacc = (P0[0] + P0[1]); __builtin_amdgcn_s_setprio(1);   \
    if (TYPE == 0) { \
    GAPA(C0 = MFMA32(kf[0], qr[0], C0), P0[2], P0[3], P0[4], P0[5],     pw0[0] = PKW(P0, 0), pw0[1] = PKW(P0, 2), pw0); \
    VRD(4); SBAR(); GAPA(C1 = MFMA32(kf[1], qr[0], C1), P0[6], P0[7], P0[8], P0[9],     pw0[2] = PKW(P0, 4), pw0[3] = PKW(P0, 6), pw0); \
    } else { \
    GAPA(C0 = MFMA32(kf[0], qr[0], negm), P0[2], P0[3], P0[4], P0[5],     pw0[0] = PKW(P0, 0), pw0[1] = PKW(P0, 2), pw0); \
    VRD(4); SBAR(); GAPA(C1 = MFMA32(kf[1], qr[0], negm), P0[6], P0[7], P0[8], P0[9],     pw0[2] = PKW(P0, 4), pw0[3] = PKW(P0, 6), pw0); \
    } \
    VRD(1); SBAR(); GAPA(C0 = MFMA32(kf[2], qr[1], C0),   P0[10], P0[11], P0[12], P0[13], pw1[0] = PKW(P0, 8), pw1[1] = PKW(P0, 10), pw1); \
    VRD(5); SBAR(); GAPA(C1 = MFMA32(kf[3], qr[1], C1),   P0[14], P0[15], P1[0], P1[1],   pw1[2] = PKW(P0, 12), pw1[3] = PKW(P0, 14), pw1); \
    VRD(2); SBAR(); GAPA(C0 = MFMA32(kf[4], qr[2], C0),   P1[2], P1[3], P1[4], P1[5],     pw2[0] = PKW(P1, 0), pw2[1] = PKW(P1, 2), pw2); \
    VRD(6); SBAR(); GAPA(C1 = MFMA32(kf[5], qr[2], C1),   P1[6], P1[7], P1[8], P1[9],     pw2[2] = PKW(P1, 4), pw2[3] = PKW(P1, 6), pw2); \
    VRD(3); SBAR(); GAPA(C0 = MFMA32(kf[6], qr[3], C0),   P1[10], P1[11], P1[12], P1[13], pw3[0] = PKW(P1, 8), pw3[1] = PKW(P1, 10), pw3); \
    VRD(7); SBAR(); GAPA(C1 = MFMA32(kf[7], qr[3], C1),   P1[14], P1[15], 0.f, 0.f,       pw3[2] = PKW(P1, 12), pw3[3] = PKW(P1, 14), pw3); \
    __builtin_amdgcn_s_setprio(0); l_reg += sacc; \
    if (GK) { DMA_K((t) + 3, sl_cur); } if (GV) { DMA_V((t) + 1, sl_next); } \
    CMASK(C0, C1, t); \
    resc = false; \
      \
    if (!FIXED && (TYPE != 0 || __any(floor2 + wsf[64 + (LN) * 64 + 63] + cm > (float)THRL))) { float a = MX3(C0[0], C0[1], C1[0]), b_ = MX3(C0[2], C0[3], C1[1]); a = MX3(a, C1[2], C1[3]); \
      _Pragma("unroll") for (int r = 4; r < 16; r += 4) { a = MX3(a, C0[r], C0[r + 1]); b_ = MX3(b_, C0[r + 2], C0[r + 3]); a = MX3(a, C1[r], C1[r + 1]); b_ = MX3(b_, C1[r + 2], C1[r + 3]); } \
      float rm = __builtin_fmaxf(a, b_); { auto rr = __builtin_amdgcn_permlane32_swap(__float_as_uint(rm), __float_as_uint(rm), false, false); rm = __builtin_fmaxf(__uint_as_float(rr[0]), __uint_as_float(rr[1])); } \
      resc = false; \
      if (__builtin_expect(__any(rm > (float)THRL), 0)) { const float dl = __builtin_fmaxf(rm, 0.f); mhat += dl; \
        _Pragma("unroll") for (int r = 0; r < 16; ++r) { C0[r] -= dl; C1[r] -= dl; } \
        if (TYPE == 0) cm = cref2 - mhat; \
        else { nm = cur_sel ? -mhat : -INFINITY; NEGM_SET(); } \
        const float f = __builtin_amdgcn_exp2f(-dl); l_reg *= f; if (hi == 0) wsf[r32] = f; resc = true; } } \
    SBAR(); __builtin_amdgcn_s_setprio(1); \
    GAPB(o[0] = MFMA32(PAF(0), VFR(0), o[0]), C0, 0); \
    GAPB(o[1] = MFMA32(PAF(0), VFR(4), o[1]), C0, 4); \
    KRD(GL, 0); GAPB(o[0] = MFMA32(PAF(1), VFR(1), o[0]), C0, 8); \
    KRD(GL, 1); GAPB(o[1] = MFMA32(PAF(1), VFR(5), o[1]), C0, 12); \
    KRD(GL, 2); GAPB(o[0] = MFMA32(PAF(2), VFR(2), o[0]), C1, 0); \
    KRD(GL, 3); GAPB(o[1] = MFMA32(PAF(2), VFR(6), o[1]), C1, 4); \
    GAPB(o[0] = MFMA32(PAF(3), VFR(3), o[0]), C1, 8); \
    GAPB(o[1] = MFMA32(PAF(3), VFR(7), o[1]), C1, 12); __builtin_amdgcn_s_setprio(0); \
    } while (0)
    int t = 1;
#undef CMASK
#define CMASK(P0, P1, t) do { } while (0)
    for (; t + 5 < NT; t += 2) {
        STEP(pB0, pB1, pA0, pA1, t, true, true, true, 1);     WAIT_BAR(2); RESC(); ROT();
        STEP(pA0, pA1, pB0, pB1, t + 1, true, true, true, 0); WAIT_BAR(2); RESC(); ROT();
    }
#undef CMASK
#define CMASK(P0, P1, t) do { int jb_ = (t) - (NT - 4); if (jb_ >= 0) cmask(P0, P1, jb_, qrel, hi); } while (0)
#define ENDW(tt) do { if ((tt) + 3 < NT) { WAIT_BAR(2); } else if ((tt) + 2 < NT) { WAIT_BAR(1); } else { WAIT_BAR(0); } } while (0)
    for (; t + 1 < NT; t += 2) {
        STEP(pB0, pB1, pA0, pA1, t, (t + 3 < NT), (t + 1 < NT), (t + 1 < NT), 1);         ENDW(t);     RESC(); ROT();
        STEP(pA0, pA1, pB0, pB1, t + 1, (t + 4 < NT), (t + 2 < NT), (t + 2 < NT), 0);     ENDW(t + 1); RESC(); ROT();
    }
    STEP(pB0, pB1, pA0, pA1, NT - 1, false, false, false, 1); RESC();
    u32x4 zq0, zq1, zq2, zq3; int rotn = -1;
    { const h16* Zw_ = Zs + headoff + (size_t)(q0 + wid * QBLK + (lane >> 3)) * PT + (lane & 7) * 8;
      asm volatile("global_load_dwordx4 %0, %1, off" : "=v"(zq0) : "v"(Zw_) : "memory");
      asm volatile("global_load_dwordx4 %0, %1, off" : "=v"(zq1) : "v"(Zw_ + 8 * PT) : "memory");
      asm volatile("global_load_dwordx4 %0, %1, off" : "=v"(zq2) : "v"(Zw_ + 16 * PT) : "memory");
      asm volatile("global_load_dwordx4 %0, %1, off" : "=v"(zq3) : "v"(Zw_ + 24 * PT) : "memory"); }
    if (ntype >= 0) { rotn = sl_next / SLOTB; const int a0 = sl_next, a1 = NXTS(a0), a2 = NXTS(a1);
        const h16* nks = nKt + (size_t)lane * PT + wid * 8; const h16* nvs = nVt + (size_t)(16 * (wid & 3) + (lane >> 2)) * PT + (wid >> 2) * 32 + (lane & 3) * 8;
        glds16(nks, (unsigned)__builtin_amdgcn_readfirstlane(kdst + a0)); glds16(nvs, (unsigned)__builtin_amdgcn_readfirstlane(vdst + a0));
        glds16(nks + (size_t)KVBLK * PT, (unsigned)__builtin_amdgcn_readfirstlane(kdst + a1));
        if (ntype == 0) glds4(ncb1 + lane, (unsigned)__builtin_amdgcn_readfirstlane(lds0 + LDS_WS + wid * 1024 + 256 + 256));
        glds16(nks + (size_t)2 * KVBLK * PT, (unsigned)__builtin_amdgcn_readfirstlane(kdst + a2)); }
    { float sacc = pB0[0] + pB0[1];
#pragma unroll
      for (int r = 2; r < 16; ++r) sacc += pB0[r];
#pragma unroll
      for (int r = 0; r < 16; ++r) sacc += pB1[r];
      l_reg += sacc;
      pw0 = (u32x4){PKW(pB0, 0), PKW(pB0, 2), PKW(pB0, 4), PKW(pB0, 6)}; pw1 = (u32x4){PKW(pB0, 8), PKW(pB0, 10), PKW(pB0, 12), PKW(pB0, 14)};
      pw2 = (u32x4){PKW(pB1, 0), PKW(pB1, 2), PKW(pB1, 4), PKW(pB1, 6)}; pw3 = (u32x4){PKW(pB1, 8), PKW(pB1, 10), PKW(pB1, 12), PKW(pB1, 14)};
      SBAR(); pv(o, vb0 + sl_cur, PAF(0), PAF(1), PAF(2), PAF(3)); }
#undef PKW
#undef PAF
#undef VFR
#undef PIN
#undef MX3
#undef GAPA
#undef GAPB
#undef EX
#undef VRD
#undef KRD
#undef STEP
#undef ENDW
#undef CINIT
    { auto rr = __builtin_amdgcn_permlane32_swap(__float_as_uint(l_reg), __float_as_uint(l_reg), false, false); l_reg = __uint_as_float(rr[0]) + __uint_as_float(rr[1]); }
    if (hi == 0) wsf[32 + r32] = l_reg; asm volatile("s_waitcnt lgkmcnt(0)" ::: "memory");
    float rli[16];
#pragma unroll
    for (int r = 0; r < 16; ++r) rli[r] = __builtin_amdgcn_rcpf(wsf[32 + crow(r, hi)] * -LOG2E);
    { LAS h16* stg = (LAS h16*)(shm + LDS_OST) + wid * 2048;
      int le = lane; asm volatile("" : "+v"(le));
      const int r32e = le & 31, hie = le >> 5;
#pragma unroll
      for (int r = 0; r < 16; ++r) { const int orow = crow(r, hie);
#pragma unroll
          for (int d0 = 0; d0 < 2; ++d0) stg[orow * 64 + d0 * 32 + r32e] = (h16)(o[d0][r] * rli[r]); }
      asm volatile("s_waitcnt lgkmcnt(0)" ::: "memory");
      h16* Yw = Y + ((size_t)b * SEQ + q0 + wid * QBLK) * 1024 + TYPE * 512 + h * HD;
      if (ntype == 0) asm volatile("s_waitcnt vmcnt(5)" : "+v"(zq0), "+v"(zq1), "+v"(zq2), "+v"(zq3) :: "memory");
      else if (ntype == 1) asm volatile("s_waitcnt vmcnt(4)" : "+v"(zq0), "+v"(zq1), "+v"(zq2), "+v"(zq3) :: "memory");
      else asm volatile("s_waitcnt vmcnt(0)" : "+v"(zq0), "+v"(zq1), "+v"(zq2), "+v"(zq3) :: "memory");
      f16x8 zq[4] = {__builtin_bit_cast(f16x8, zq0), __builtin_bit_cast(f16x8, zq1), __builtin_bit_cast(f16x8, zq2), __builtin_bit_cast(f16x8, zq3)};
#pragma unroll
      for (int i = 0; i < 4; ++i) { const int row = i * 8 + (le >> 3), ch = le & 7; const f16x8 ov = *(const LAS f16x8*)(stg + row * 64 + ch * 8);
          const f16x8 zv = zq[i];
          u32x4 w; w.x = cvtpk_s((float)ov[0] * (float)zv[0], (float)ov[1] * (float)zv[1]); w.y = cvtpk_s((float)ov[2] * (float)zv[2], (float)ov[3] * (float)zv[3]);
          w.z = cvtpk_s((float)ov[4] * (float)zv[4], (float)ov[5] * (float)zv[5]); w.w = cvtpk_s((float)ov[6] * (float)zv[6], (float)ov[7] * (float)zv[7]);
          *(u32x4*)(Yw + (size_t)row * 1024 + ch * 8) = w; } }
    asm volatile("s_waitcnt lgkmcnt(0)\n\ts_barrier" ::: "memory");
    return rotn;
#undef NXTS
#undef NEGM_SET
#undef DMA_K
#undef DMA_V
#undef DMA_B
#undef CMASK
#undef RESC
#undef ROT
}
#undef SBAR
#undef WAIT_BAR
#undef MFMA32
#undef F8
}

#define GAS __attribute__((address_space(1)))
typedef GAS unsigned gu32;
#define RLX_AGENT __ATOMIC_RELAXED, __HIP_MEMORY_SCOPE_AGENT
#define XB_TMO      128
#define XB_XCNT(j)  (256  + 64 * (j))
#define XB_XSUB(j)  (1280 + 64 * (j))
#define XB_XGEN(j)  (2304 + 64 * (j))
#define XB_TOP      3328
#define XB_TOPGEN   3392
#define XCD_BAR_WORDS 3456
#define XB_SPIN_CAP (1u << 18)

__device__ __forceinline__ unsigned xb_ld(unsigned* p)              { return __hip_atomic_load(p, __ATOMIC_RELAXED, __HIP_MEMORY_SCOPE_AGENT); }
__device__ __forceinline__ unsigned xb_add(unsigned* p, unsigned v) { return __hip_atomic_fetch_add(p, v, __ATOMIC_RELAXED, __HIP_MEMORY_SCOPE_AGENT); }
__device__ __forceinline__ unsigned xb_xcc_id() { return (unsigned)__builtin_amdgcn_s_getreg((3 << 11) | 20) & 0xFu; }
#define XB_SPIN(cond, bar) do { unsigned _sp = 0; while (cond) { __builtin_amdgcn_s_sleep(1); \
    if ((++_sp & 255u) == 0u) { if (xb_ld(&(bar)[XB_TMO])) break; if (_sp > XB_SPIN_CAP) { atomicAdd(&(bar)[XB_TMO], 1u); break; } } } } while (0)

struct XcdBarrier {
    unsigned* bar; unsigned x;
    volatile LAS unsigned* st;
};

__device__ __forceinline__ XcdBarrier xcd_barrier_post(unsigned* bar, volatile LAS unsigned* st) {
    XcdBarrier b; b.bar = bar; b.x = xb_xcc_id(); b.st = st;
    if (threadIdx.x == 0) st[4] = xb_add(&bar[XB_XCNT(b.x)], 1u) + 1u;
    return b;
}
__device__ __forceinline__ void xcd_barrier_complete(unsigned* bar, unsigned x, unsigned& nloc, unsigned& nx, unsigned& uni) {
    const unsigned G = gridDim.x * gridDim.y * gridDim.z;
    unsigned sum, cnt, mine, full, sp = 0u;
    for (;;) {
        sum = 0u; cnt = 0u; mine = 0u; full = 0u;
#pragma unroll
        for (unsigned j = 0; j < 16; ++j) { const unsigned c = xb_ld(&bar[XB_XCNT(j)]); sum += c; cnt += (c > 0u) ? 1u : 0u; mine = (j == x) ? c : mine; full += (j < 8u && c == 32u) ? 1u : 0u; }
        if (sum == G) break;
        __builtin_amdgcn_s_sleep(1);
        if ((++sp & 255u) == 0u) { if (xb_ld(&bar[XB_TMO])) break; if (sp > XB_SPIN_CAP) { atomicAdd(&bar[XB_TMO], 1u); break; } }
    }
    nloc = mine > 0u ? mine : 1u; nx = cnt > 0u ? cnt : 1u;
    uni = (sum == G && G == 256u && full == 8u) ? 1u : 2u;
}

__device__ __forceinline__ void xcd_barrier(const XcdBarrier& b) {
    asm volatile("s_waitcnt vmcnt(0)" ::: "memory");
    __syncthreads();
    if (threadIdx.x == 0) {
        unsigned* bar = b.bar;
        __builtin_amdgcn_s_waitcnt(0);
        unsigned nloc = b.st[0], nx = b.st[1];
        if (nloc == 0u) { unsigned uni; xcd_barrier_complete(bar, b.x, nloc, nx, uni); b.st[0] = nloc; b.st[1] = nx; b.st[2] = uni; }
        const unsigned old = xb_add(&bar[XB_XSUB(b.x)], 1u);
        const unsigned gen = old / nloc;
        if (old + 1u == (gen + 1u) * nloc) {
            __builtin_amdgcn_fence(__ATOMIC_RELEASE, "agent");
            asm volatile("s_waitcnt vmcnt(0)" ::: "memory");
            const unsigned og = xb_add(&bar[XB_TOP], 1u);
            const unsigned tg = og / nx;
            if (og + 1u == (tg + 1u) * nx) xb_add(&bar[XB_TOPGEN], 1u);
            else XB_SPIN(xb_ld(&bar[XB_TOPGEN]) == tg, bar);
            __builtin_amdgcn_fence(__ATOMIC_ACQUIRE, "agent");
            xb_add(&bar[XB_XGEN(b.x)], 1u);
            asm volatile("s_waitcnt vmcnt(0)" ::: "memory");
        } else {
            XB_SPIN(xb_ld(&bar[XB_XGEN(b.x)]) == gen, bar);
            __builtin_amdgcn_fence(__ATOMIC_ACQUIRE, "agent");
            asm volatile("s_waitcnt vmcnt(0)" ::: "memory");
        }
    }
    __syncthreads();
}

__device__ __forceinline__ float wave_sum(float v) {
#pragma unroll
    for (int o = 1; o < 64; o <<= 1) v += __shfl_xor(v, o);
    return v;
}
template <bool ZSC = false>
__device__ __forceinline__ void p0_transpose_item(const float* W, int ldw, h16* WT, int ldt, int nblk, LAS float* scr, int item, int lane) {
    const int kb = item / nblk, nb = item % nblk, k0 = 64 * kb, n0 = 32 * nb;
    const float wsc = (ZSC && n0 < 4096 && (((n0 >> 9) & 3) == 3)) ? -LOG2E : 1.0f;
#pragma unroll 8
    for (int i = 0; i < 32; ++i) { const int kk = 2 * i + (lane >> 5); scr[kk * 33 + (lane & 31)] = W[(size_t)(k0 + kk) * ldw + n0 + (lane & 31)] * wsc; }
    asm volatile("s_waitcnt lgkmcnt(0)" ::: "memory");
    const int c = lane & 7;
#pragma unroll
    for (int j = 0; j < 4; ++j) { const int n = (lane >> 3) + 8 * j; const LAS float* s = scr + (8 * c) * 33 + n;
        u32x4 o; o.x = pg8::cvt_pk_f16(s[0 * 33], s[1 * 33]); o.y = pg8::cvt_pk_f16(s[2 * 33], s[3 * 33]); o.z = pg8::cvt_pk_f16(s[4 * 33], s[5 * 33]); o.w = pg8::cvt_pk_f16(s[6 * 33], s[7 * 33]);
        *(u32x4*)(WT + (size_t)(n0 + n) * ldt + k0 + 8 * c) = o; }
    asm volatile("s_waitcnt lgkmcnt(0)" ::: "memory");
}
__device__ __forceinline__ void sincos_d(double a, double& s, double& c) {
    const double kq = rint(a * 0.63661977236758134308);
    double r = fma(-kq, 1.57079632679489655800e+00, a); r = fma(-kq, 6.12323399573676603587e-17, r);
    const int q = ((int)kq) & 3; const double r2 = r * r;
    const double sp = r * (1.0 + r2 * (-1.0 / 6 + r2 * (1.0 / 120 + r2 * (-1.0 / 5040 + r2 * (1.0 / 362880 + r2 * (-1.0 / 39916800 + r2 * (1.0 / 6227020800.0 + r2 * (-1.0 / 1307674368000.0))))))));
    const double cp = 1.0 + r2 * (-0.5 + r2 * (1.0 / 24 + r2 * (-1.0 / 720 + r2 * (1.0 / 40320 + r2 * (-1.0 / 3628800 + r2 * (1.0 / 479001600 + r2 * (-1.0 / 87178291200.0 + r2 * (1.0 / 20922789888000.0))))))));
    s = (q == 0) ? sp : (q == 1) ? cp : (q == 2) ? -sp : -cp;
    c = (q == 0) ? cp : (q == 1) ? -sp : (q == 2) ? -cp : sp;
}

#define XPREF 1
struct Args { const float* in[12]; float* out; unsigned char* ws; int ph_lo, ph_hi; };

__global__ void __launch_bounds__(NWAVES * 64, 2) fwd(Args args) {
    extern __shared__ __attribute__((aligned(16))) unsigned char lds_raw[];
    LAS unsigned char* lds = (LAS unsigned char*)lds_raw;
    const int tid = threadIdx.x, lane = tid & 63, wave = __builtin_amdgcn_readfirstlane(tid >> 6);
    const int G = gridDim.x; const int bx = blockIdx.x; const int vcu = (G % 8 == 0) ? (bx % 8) * (G / 8) + bx / 8 : bx;
    unsigned char* ws = args.ws;
    volatile LAS unsigned* MISC = (volatile LAS unsigned*)(lds + RING_BYTES);
    if (tid < 32) MISC[tid] = 0u;
    __syncthreads();
    XcdBarrier bar = xcd_barrier_post((unsigned*)(ws + WS_CTL) + 1024, MISC + 8);
    const float* x = args.in[0]; const float* norm_g = args.in[1]; const float* w_in = args.in[2]; const float* b_f = args.in[3]; const float* b_gate = args.in[4];
    const float* w_fox = args.in[9]; const float* w_moba = args.in[10]; const float* w_out = args.in[11];
    h16* Win_t = (h16*)(ws + WS_WIN); h16* Wcat_t = (h16*)(ws + WS_WCAT); h16* Wout_t = (h16*)(ws + WS_WOUT);
    float* rope = (float*)(ws + WS_ROPE); float* logf_ = (float*)(ws + WS_LOGF); float* cum = (float*)(ws + WS_CUM); float* kmean = (float*)(ws + WS_KMEAN); float* gtab = (float*)(ws + WS_GTAB);
    h16* XN = (h16*)(ws + WS_XN); h16* Y = (h16*)(ws + WS_Y); h16* bufs = (h16*)(ws + WS_BUFS); h16* MERGED = (h16*)(ws + WS_MERGED);
    h16* GA = (h16*)(ws + WS_GA); h16* GB = (h16*)(ws + WS_GB); float* irs = (float*)(ws + WS_IRS);
    const int lo = args.ph_lo, hi_ = args.ph_hi;
#define IN(k) (lo <= (k) && (k) < hi_)
#define GRID_BAR(k) do { if (IN(k) && IN((k) + 1)) xcd_barrier(bar); } while (0)

    if (IN(0)) {
        LAS float* scr = (LAS float*)(lds + wave * 16384);
        const int gw = vcu * NWAVES + wave, NGW = G * NWAVES;
        constexpr int I_IN = (DM / 64) * (IN_WG / 32), I_F = (512 / 64) * (DM / 32), I_O = (DM / 64) * (DM / 32);
        constexpr int NITEMS = I_IN + 2 * I_F + I_O;
        for (int it = gw; it < NITEMS; it += NGW) {
            int r = it;
            if (r < I_IN) { p0_transpose_item<true>(w_in, IN_W, Win_t, DM, IN_WG / 32, scr, r, lane); continue; } r -= I_IN;
            if (r < I_F) { p0_transpose_item(w_fox, DM, Wcat_t, DM, DM / 32, scr, r, lane); continue; } r -= I_F;
            if (r < I_F) { p0_transpose_item(w_moba, DM, Wcat_t + 512, DM, DM / 32, scr, r, lane); continue; } r -= I_F;
            p0_transpose_item(w_out, DM, Wout_t, DM, DM / 32, scr, r, lane);
        }
        { const int gid = bx * 512 + tid;
          if (gid < BATCH * NH * 16 * HD) kmean[gid] = 0.f;
          if (gid < 256) { const int wch = gid >> 6; const float* src = args.in[5 + wch]; gtab[gid] = src[gid & 63] * (((wch & 1) == 0) ? 8.0f * QSCALE : 8.0f); }
          if (gid < SEQ * 8) { const int pos = gid >> 3, i = gid & 7;
              const float invf = (i == 0) ? 1.0f : (i == 1) ? 0.1939227432012558f : (i == 2) ? 0.03760603070259094f : (i == 3) ? 0.007292664609849453f : (i == 4) ? 0.0014142135623842478f
                               : (i == 5) ? 0.00027424818836152554f : (i == 6) ? 5.3182957344688475e-05f : 1.0313385246263351e-05f;
              const float ang = (float)pos * invf; double s, c; sincos_d((double)ang, s, c); rope[gid] = (float)c; rope[SEQ * 8 + gid] = (float)s; } }
        __syncthreads();
        { LAS f32x4* gwl = (LAS f32x4*)lds;
          for (int i = tid; i < DM * 2; i += NWAVES * 64) { const int k = i >> 1, hf = i & 1; gwl[i] = *(const f32x4*)(w_in + (size_t)k * IN_W + IN_WG + 4 * hf) * norm_g[k]; } }
        __syncthreads();
        f32x4 gv[4]; f32x4 gw0[4][4], gw1[4][4];
#pragma unroll
        for (int j = 0; j < 4; ++j) { gv[j] = *(const f32x4*)(norm_g + 256 * j + 4 * lane);
#pragma unroll
            for (int e = 0; e < 4; ++e) { const LAS f32x4* wp = (const LAS f32x4*)lds + (256 * j + 4 * lane + e) * 2; gw0[j][e] = wp[0]; gw1[j][e] = wp[1]; } }
        const int hsel = (lane >> 3) & 7;
        const float bfl = b_f[((lane >> 5) & 1) * 4 + ((lane >> 4) & 1) * 2 + ((lane >> 3) & 1)];
        f32x4 v[4];
        if (gw < M) {
#pragma unroll
            for (int j = 0; j < 4; ++j) v[j] = ((const f32x4*)(x + (size_t)gw * DM) + lane)[64 * j]; }
        for (int m = gw; m < M; m += NGW) {
            f32x4 nv[4];
            const int mn = (m + NGW < M) ? m + NGW : m;
#pragma unroll
            for (int j = 0; j < 4; ++j) nv[j] = ((const f32x4*)(x + (size_t)mn * DM) + lane)[64 * j];
            float ss = 0.f; f32x4 d0 = {0.f, 0.f, 0.f, 0.f}, d1 = {0.f, 0.f, 0.f, 0.f};
#pragma unroll
            for (int j = 0; j < 4; ++j) { ss += (v[j].x * v[j].x + v[j].y * v[j].y) + (v[j].z * v[j].z + v[j].w * v[j].w);
#pragma unroll
                for (int e = 0; e < 4; ++e) { d0 += gw0[j][e] * v[j][e]; d1 += gw1[j][e] * v[j][e]; } }
            ss = wave_sum(ss);
            const float rvar = sqrtf(ss * (1.0f / DM) + RMS_EPS); const float rstd = 1.0f / rvar;
            if (lane == 0) irs[m] = rvar;
            f32x4 a4; { const bool up = (lane & 32) != 0; const f32x4 keep = up ? d1 : d0, send = up ? d0 : d1;
#pragma unroll
                for (int e = 0; e < 4; ++e) a4[e] = keep[e] + __shfl_xor(send[e], 32); }
            f32x2 a2; { const bool up = (lane & 16) != 0; const f32x2 keep = up ? (f32x2){a4[2], a4[3]} : (f32x2){a4[0], a4[1]}, send = up ? (f32x2){a4[0], a4[1]} : (f32x2){a4[2], a4[3]};
                a2[0] = keep[0] + __shfl_xor(send[0], 16); a2[1] = keep[1] + __shfl_xor(send[1], 16); }
            float a1; { const bool up = (lane & 8) != 0; const float keep = up ? a2[1] : a2[0], send = up ? a2[0] : a2[1]; a1 = keep + __shfl_xor(send, 8); }
            a1 += __shfl_xor(a1, 4); a1 += __shfl_xor(a1, 2); a1 += __shfl_xor(a1, 1);
            if ((lane & 7) == 0) { const float z = a1 * rstd + bfl; const float lf = fminf(z, 0.f) - log1pf(expf(-fabsf(z)));
                const int bb = m >> 12, t = m & 4095; const int hd = ((lane >> 5) & 1) * 4 + ((lane >> 4) & 1) * 2 + ((lane >> 3) & 1); logf_[(size_t)(bb * NH + hd) * SEQ + t] = lf; }
            u32x2* o8 = (u32x2*)(XN + (size_t)m * DM) + lane;
#pragma unroll
            for (int j = 0; j < 4; ++j) { const f32x4 hv = v[j] * rstd * gv[j]; u32x2 w; w.x = pg8::cvt_pk_f16(hv[0], hv[1]); w.y = pg8::cvt_pk_f16(hv[2], hv[3]); o8[64 * j] = w; }
#pragma unroll
            for (int j = 0; j < 4; ++j) v[j] = nv[j];
        }
        (void)hsel;
        __syncthreads();
    }

    GRID_BAR(0);

    if (IN(1)) {
        if (bx < BATCH * NH) {
            const float* lf = logf_ + (size_t)bx * SEQ + tid * 8; const f32x4 a = *(const f32x4*)lf, b4 = *(const f32x4*)(lf + 4);
            double pre[8]; double s = 0.0; const float vv[8] = {a[0], a[1], a[2], a[3], b4[0], b4[1], b4[2], b4[3]};
#pragma unroll
            for (int i = 0; i < 8; ++i) { s += (double)vv[i]; pre[i] = s; }
            double incl = s;
#pragma unroll
            for (int o = 1; o < 64; o <<= 1) { const double t = __shfl_up(incl, o); if (lane >= o) incl += t; }
            LAS double* wt = (LAS double*)lds;
            if (lane == 63) wt[wave] = incl;
            __syncthreads();
            double off = incl - s;
            for (int w = 0; w < wave; ++w) off += wt[w];
            float* cp = cum + (size_t)bx * SEQ + tid * 8;
            const double nl2e = -1.4426950408889634;
            *(f32x4*)cp = (f32x4){(float)((off + pre[0]) * nl2e), (float)((off + pre[1]) * nl2e), (float)((off + pre[2]) * nl2e), (float)((off + pre[3]) * nl2e)};
            *(f32x4*)(cp + 4) = (f32x4){(float)((off + pre[4]) * nl2e), (float)((off + pre[5]) * nl2e), (float)((off + pre[6]) * nl2e), (float)((off + pre[7]) * nl2e)};
            __syncthreads();
        }
        pg8::Gemm g{XN, Win_t, M, IN_WG, DM}; pg8::DealtOrder S; S.s.init(M, IN_WG, G, bx);
        pg8::EpiInProj E{bufs, GA, GB, gtab, b_gate, rope, kmean};
        pg8::gemm_phase<pg8::EpiInProj, pg8::DealtOrder, true, true>(lds, g, S, E);
    }

    GRID_BAR(1);

    if (IN(2)) {
        const int vcu2 = ((MISC[10] == 1u) && (MISC[12] != 0u) && G == 256) ? (int)bar.x * 32 + ((int)MISC[12] - 1) : vcu;
        const int bh = vcu2 >> 3, s = vcu2 & 7, b = bh >> 3, h = bh & 7;
        if (G == 256) {
            const float* cb2h = cum + (size_t)bh * SEQ;
            float gq = fabsf(gtab[lane]) * (0.125f / QSCALE), gk = fabsf(gtab[64 + lane]) * 0.125f, mq = fabsf(gtab[128 + lane]) * (0.125f / QSCALE), mk = fabsf(gtab[192 + lane]) * 0.125f;
#pragma unroll
            for (int o = 1; o < 64; o <<= 1) { gq = fmaxf(gq, __shfl_xor(gq, o)); gk = fmaxf(gk, __shfl_xor(gk, o)); mq = fmaxf(mq, __shfl_xor(mq, o)); mk = fmaxf(mk, __shfl_xor(mk, o)); }
            const float lmax2f = 8.0f * gq * gk * LOG2E * 1.02f, lmax2m = 8.0f * mq * mk * LOG2E * 1.02f;
            const int qbA = s, qbB = 15 - s; int jsA, jsB;
            { const float ceA = (lane < 4 * qbA + 4) ? cb2h[64 * lane + 63] : 0.f, ceB = (lane < 4 * qbB + 4) ? cb2h[64 * lane + 63] : 0.f, cuA = cb2h[256 * qbA], cuB = cb2h[256 * qbB];
              const unsigned long long bA = __ballot((lane < 4 * qbA + 4) && ((ceA - cuA) + 2.0f * lmax2f >= -34.0f)), bB = __ballot((lane < 4 * qbB + 4) && ((ceB - cuB) + 2.0f * lmax2f >= -34.0f));
              jsA = __builtin_amdgcn_readfirstlane(bA ? (int)__builtin_ctzll(bA) : 0) & ~1; if (jsA > 4 * qbA) jsA = 4 * qbA;
              jsB = __builtin_amdgcn_readfirstlane(bB ? (int)__builtin_ctzll(bB) : 0) & ~1; if (jsB > 4 * qbB) jsB = 4 * qbB; }
            const size_t hoff = (size_t)bh * SEQ * HD;
            const h16 *FQ = bufs, *FK = bufs + BUF_ELEMS, *FV = bufs + 2 * BUF_ELEMS, *FZ = bufs + 3 * BUF_ELEMS, *MQ = bufs + 4 * BUF_ELEMS, *MK = bufs + 5 * BUF_ELEMS, *MV = bufs + 6 * BUF_ELEMS, *MZ = bufs + 7 * BUF_ELEMS;
            const float* kmh = kmean + (size_t)bh * 16 * HD;
            int rot = -1;
            rot = fa::attn_unit<0, 8, false>(lds, b, h, qbA, FQ, FK, FV, FZ, Y, cb2h, -cb2h[256 * qbA + 255], jsA, nullptr, lmax2f, rot,
                                             FK + hoff + (size_t)jsB * 64 * HD, FV + hoff + (size_t)jsB * 64 * HD, cb2h + jsB * 64 + 64, 0);
            rot = fa::attn_unit<0, 8, false>(lds, b, h, qbB, FQ, FK, FV, FZ, Y, cb2h, -cb2h[256 * qbB + 255], jsB, nullptr, lmax2f, rot, MK + hoff, MV + hoff, nullptr, 1);
            if (lmax2m <= 14.0f) {
                rot = fa::attn_unit<1, 8, true>(lds, b, h, qbA, MQ, MK, MV, MZ, Y, nullptr, 0.f, 0, kmh, -lmax2m, rot, MK + hoff, MV + hoff, nullptr, 1);
                (void)fa::attn_unit<1, 8, true>(lds, b, h, qbB, MQ, MK, MV, MZ, Y, nullptr, 0.f, 0, kmh, -lmax2m, rot, nullptr, nullptr, nullptr, -1);
            } else {
                rot = fa::attn_unit<1, 8, false>(lds, b, h, qbA, MQ, MK, MV, MZ, Y, nullptr, 0.f, 0, kmh, -lmax2m, rot, MK + hoff, MV + hoff, nullptr, 1);
                (void)fa::attn_unit<1, 8, false>(lds, b, h, qbB, MQ, MK, MV, MZ, Y, nullptr, 0.f, 0, kmh, -lmax2m, rot, nullptr, nullptr, nullptr, -1);
            }
        }
    }

    GRID_BAR(2);

    const bool uni = (MISC[10] == 1u) && (MISC[12] != 0u) && G == 256;
    pg8::OneTile T34;
    if (uni) { const int rk = (int)MISC[12] - 1; T34.pm = 8 * (int)bar.x + (rk & 7); T34.pn = rk >> 3; }
    else { pg8::StaticOrder S; S.init(M, DM, G, bx); pg8::Unit u0; u0.pm = 0; u0.pn = 0; (void)S.next(0, u0); T34.pm = u0.pm; T34.pn = u0.pn; }

    if (IN(3)) {
        pg8::Gemm g{Y, Wcat_t, M, DM, DM};
        pg8::EpiMerge E{(const unsigned char*)GA, (const unsigned char*)GB, MERGED};
        pg8::gemm_phase<pg8::EpiMerge, pg8::OneTile, false>(lds, g, T34, E);
    }

    GRID_BAR(3);

    if (IN(4)) {
        pg8::Gemm g{MERGED, Wout_t, M, DM, DM};
        pg8::EpiOut E{x, args.out, XN, irs, norm_g};
        pg8::gemm_phase<pg8::EpiOut, pg8::OneTile, false>(lds, g, T34, E);
    }
#undef IN
#undef GRID_BAR
}

extern "C" void kernel_launch(void* const* d_in, const int* in_sizes, int n_in, void* d_out, int out_size, void* d_ws, size_t ws_size, hipStream_t stream) {
    static int grid = 0;
    if (grid == 0) {
        if (n_in != 12 || in_sizes[0] != M * DM || out_size != M * DM || ws_size < WS_END) { fprintf(stderr, "kernel_launch: unexpected shapes (n_in %d, in0 %d, out %d, ws %zu)\n", n_in, n_in > 0 ? in_sizes[0] : -1, out_size, ws_size); grid = -1; return; }
        if (hipFuncSetAttribute((const void*)fwd, hipFuncAttributeMaxDynamicSharedMemorySize, LDS_BYTES) != hipSuccess) { fprintf(stderr, "kernel_launch: hipFuncSetAttribute failed\n"); grid = -1; return; }
        int dev = 0, cus = 0, per_cu = 0; (void)hipGetDevice(&dev); (void)hipDeviceGetAttribute(&cus, hipDeviceAttributeMultiprocessorCount, dev);
        if (hipOccupancyMaxActiveBlocksPerMultiprocessor(&per_cu, (const void*)fwd, NWAVES * 64, LDS_BYTES) != hipSuccess || per_cu < 1) { fprintf(stderr, "kernel_launch: occupancy query says %d blocks per CU\n", per_cu); grid = -1; return; }
        grid = cus;
        if (grid != 256) fprintf(stderr, "kernel_launch: %d CUs (built for 256)\n", grid);
    }
    if (grid < 0) return;
    Args a{};
    for (int i = 0; i < 12; ++i) a.in[i] = (const float*)d_in[i];
    a.out = (float*)d_out; a.ws = (unsigned char*)d_ws; a.ph_lo = 0; a.ph_hi = 5;
    if (hipMemsetAsync((char*)d_ws + WS_CTL, 0, CTL_ZERO_BYTES, stream) != hipSuccess) { fprintf(stderr, "kernel_launch: hipMemsetAsync failed\n"); return; }
    hipLaunchKernelGGL(fwd, dim3(grid), dim3(NWAVES * 64), LDS_BYTES, stream, a);
    const hipError_t e = hipPeekAtLastError();
    if (e != hipSuccess) fprintf(stderr, "kernel_launch: launch failed: %s (grid %d)\n", hipGetErrorString(e), grid);
}
```

```cpp
#include <hip/hip_runtime.h>
#include <cstdio>
#include <cstdint>

#define LAS __attribute__((address_space(3)))
typedef _Float16 h16;
typedef _Float16 f16x8 __attribute__((ext_vector_type(8)));
typedef _Float16 f16x2 __attribute__((ext_vector_type(2)));
typedef float f32x2 __attribute__((ext_vector_type(2)));
typedef float f32x4 __attribute__((ext_vector_type(4)));
typedef float f32x16 __attribute__((ext_vector_type(16)));
typedef unsigned u32x4 __attribute__((ext_vector_type(4)));
typedef unsigned u32x2 __attribute__((ext_vector_type(2)));
typedef short s16x4 __attribute__((ext_vector_type(4)));

constexpr int BATCH = 4, SEQ = 4096, DM = 1024, NH = 8, HD = 64, M = BATCH * SEQ;
constexpr int IN_W = 6152, IN_WG = 6144;
constexpr float RMS_EPS = 1e-6f;
constexpr float LOG2E = 1.4426950408889634f;
constexpr float QSCALE = 0.125f * 1.4426950408889634f;
constexpr int NWAVES = 8;

constexpr size_t MiB = 1u << 20;
constexpr size_t WS_CTL = 0, CTL_ZERO_BYTES = 64 * 1024;
constexpr size_t WS_WIN = 2 * MiB;
constexpr size_t WS_WCAT = 14 * MiB;
constexpr size_t WS_WOUT = 16 * MiB;
constexpr size_t WS_ROPE = 18 * MiB;
constexpr size_t WS_LOGF = 19 * MiB;
constexpr size_t WS_CUM = 19 * MiB + 512 * 1024;
constexpr size_t WS_KMEAN = 20 * MiB;
constexpr size_t WS_GTAB = 21 * MiB;
constexpr size_t WS_IRS = 21 * MiB + 256 * 1024;
constexpr size_t WS_XN = 32 * MiB;
constexpr size_t WS_Y = 224 * MiB;
constexpr size_t WS_BUFS = 64 * MiB;
constexpr size_t BUF_ELEMS = (size_t)M * 512;
constexpr size_t WS_MERGED = 64 * MiB;
constexpr size_t WS_GA = 192 * MiB, WS_GB = 208 * MiB;
constexpr size_t WS_END = 256 * MiB;

constexpr int RING_BYTES = 131072;
constexpr int LDS_BYTES = 147456;

__device__ __forceinline__ int lane_fresh() { unsigned z; asm volatile("v_mov_b32 %0, 0" : "=v"(z)); return (int)__builtin_amdgcn_mbcnt_hi(~0u, __builtin_amdgcn_mbcnt_lo(~0u, z)); }

namespace pg8 {
constexpr int BM = 256, BK = 64, HALF = 128, HTB = HALF * BK * 2, STAGE_BYTES = 8 * HTB, NXCD = 8, WGM = 8;
__host__ __device__ __forceinline__ int lds_byte(int r, int c) { const int st = (r >> 4) * 2 + (c >> 5), rr = r & 15, cc = c & 31, ob = rr * 64 + cc * 2; return st * 1024 + (ob ^ (((ob >> 9) & 1) << 5)); }
__host__ __device__ __forceinline__ void stage_rc(int b, int& R, int& C) { const int st = b / 1024, sb = b % 1024, swz = sb ^ (((sb >> 9) & 1) << 5); R = (st >> 1) * 16 + swz / 64; C = (st & 1) * 32 + (swz % 64) / 2; }
__host__ __device__ __forceinline__ int perm32(int rho) { const int n = rho >> 4, i = rho & 15; return 8 * (i >> 2) + 4 * n + (i & 3); }

struct Unit { int pm, pn; };
struct Gemm { const h16* A; const h16* Bt; int M, N, K; };

__device__ __forceinline__ int lane_fresh_() { return lane_fresh(); }
struct StaticOrder {
    int nM, nN, nwg, G, c;
    __host__ __device__ void init(int M_, int N_, int G_, int c_) { nM = M_ / BM; nN = N_ / BM; nwg = nM * nN; G = G_; c = c_; }
    __host__ __device__ bool next(int i, Unit& u) const {
        const long L = (long)i * G + c; if (L >= nwg) return false;
        int wgid = (int)L; { const int q = nwg / NXCD, r = nwg % NXCD, xcd = wgid % NXCD, off = wgid / NXCD; wgid = (xcd < r ? xcd * (q + 1) : r * (q + 1) + (xcd - r) * q) + off; }
        const int nig = WGM * nN, gid = wgid / nig, fm = gid * WGM, gsz = (nM - fm) < WGM ? (nM - fm) : WGM;
        u.pm = fm + ((wgid % nig) % gsz); u.pn = (wgid % nig) / gsz; return true;
    }
};

struct OneTile { int pm, pn; __host__ __device__ bool next(int i, Unit& u) const { if (i != 0) return false; u.pm = pm; u.pn = pn; return true; } };
struct DealtOrder {
    StaticOrder s;
    __host__ __device__ bool next(int i, Unit& u) const { if (!s.next(i, u)) return false; if (u.pn < 16) u.pn = (int)((0xDFCEBA9875643210ull >> (4 * u.pn)) & 15ull); return true; }
};

__device__ __forceinline__ unsigned cvt_pk_f16(float lo, float hi) { f32x2 v = {lo, hi}; f16x2 h = __builtin_convertvector(v, f16x2); return __builtin_bit_cast(unsigned, h); }

struct NoPre { __device__ __forceinline__ void operator()() const {} };
struct CumsumPre { const float* logf_; float* cum; int bx; LAS unsigned char* lds;
    __device__ __forceinline__ void operator()() const { const int tid = threadIdx.x, lane = tid & 63, wave = __builtin_amdgcn_readfirstlane(tid >> 6);
        if (bx < BATCH * NH) {
            const float* lf = logf_ + (size_t)bx * SEQ + tid * 8; const f32x4 a = *(const f32x4*)lf, b4 = *(const f32x4*)(lf + 4);
            double pre[8]; double s = 0.0; const float vv[8] = {a[0], a[1], a[2], a[3], b4[0], b4[1], b4[2], b4[3]};
#pragma unroll
            for (int i = 0; i < 8; ++i) { s += (double)vv[i]; pre[i] = s; }
            double incl = s;
#pragma unroll
            for (int o = 1; o < 64; o <<= 1) { const double t = __shfl_up(incl, o); if (lane >= o) incl += t; }
            LAS double* wt = (LAS double*)(lds + RING_BYTES + 2048);
            if (lane == 63) wt[wave] = incl;
            __syncthreads();
            double off = incl - s;
            for (int w = 0; w < wave; ++w) off += wt[w];
            float* cp = cum + (size_t)bx * SEQ + tid * 8;
            const double nl2e = -1.4426950408889634;
            *(f32x4*)cp = (f32x4){(float)((off + pre[0]) * nl2e), (float)((off + pre[1]) * nl2e), (float)((off + pre[2]) * nl2e), (float)((off + pre[3]) * nl2e)};
            *(f32x4*)(cp + 4) = (f32x4){(float)((off + pre[4]) * nl2e), (float)((off + pre[5]) * nl2e), (float)((off + pre[6]) * nl2e), (float)((off + pre[7]) * nl2e)};
        }
    } };
template <class Epi, class Sched, bool ALIGN_EPI = false, bool PEEL = false, int AUXA = 0, class Pre = NoPre, class Mid = NoPre>
__device__ __forceinline__ void gemm_phase(LAS unsigned char* lds, const Gemm g, const Sched& S, const Epi& E, const Pre pre = Pre(), const Mid mid = Mid()) {
    const int tid = threadIdx.x, wid = __builtin_amdgcn_readfirstlane(tid >> 6), lane = tid & 63, wr = wid >> 2, wc = wid & 3, fr = lane & 15, fq = lane >> 4;
    const int K = g.K, nt = K / BK;
    unsigned voffA[2], voffB[2];
#pragma unroll
    for (int i = 0; i < 2; ++i) { int R, C; stage_rc(tid * 16 + i * 8192, R, C); const int Rb = 64 * (R >> 5) + perm32(R & 31);
        voffA[i] = (unsigned)(R * K + C) * 2u; voffB[i] = (unsigned)(Rb * K + C) * 2u; }
    const size_t kstep = (size_t)(BK * 2);
    const size_t hstep = (size_t)HALF * K * 2;
    const size_t bstep = (size_t)32 * K * 2;
    const size_t tstep = 2 * hstep;
    const unsigned ldsw = (unsigned)wid * 1024u;
    const int aoff = lds_byte(wr * 64 + fr, fq * 8), boff = lds_byte(wc * 32 + fr, fq * 8);
#define PG8_SA(b, h) (((b) * 2 + (h)) * HTB)
#define PG8_SB(b, h) ((4 + (b) * 2 + (h)) * HTB)
#define PG8_STAGE(bufoff, gbase, voff) do { _Pragma("unroll") for (int _i = 0; _i < 2; ++_i) { \
        if ((bufoff) < 4 * HTB) __builtin_amdgcn_global_load_lds((const unsigned*)((const char*)(gbase) + (voff)[_i]), (LAS unsigned*)(lds + (bufoff) + ldsw + _i * 8192), 16, 0, AUXA); \
        else __builtin_amdgcn_global_load_lds((const unsigned*)((const char*)(gbase) + (voff)[_i]), (LAS unsigned*)(lds + (bufoff) + ldsw + _i * 8192), 16, 0, 0); } } while (0)
#define PG8_LDA(dst, b, h) do { _Pragma("unroll") for (int m = 0; m < 4; ++m) _Pragma("unroll") for (int k = 0; k < 2; ++k) dst[m][k] = *(const LAS f16x8*)(lds + PG8_SA(b, h) + aoff + m * 2048 + k * 1024); } while (0)
#define PG8_LDB(dst, b, h) do { _Pragma("unroll") for (int n = 0; n < 2; ++n) _Pragma("unroll") for (int k = 0; k < 2; ++k) dst[n][k] = *(const LAS f16x8*)(lds + PG8_SB(b, h) + boff + n * 2048 + k * 1024); } while (0)
#define PG8_MMA(ai, bj, At, Bt) do { __builtin_amdgcn_s_setprio(1); _Pragma("unroll") for (int m = 0; m < 4; ++m) _Pragma("unroll") for (int n = 0; n < 2; ++n) _Pragma("unroll") for (int k = 0; k < 2; ++k) \
        acc[ai][bj][m][n] = __builtin_amdgcn_mfma_f32_16x16x32_f16(Bt[n][k], At[m][k], acc[ai][bj][m][n], 0, 0, 0); __builtin_amdgcn_s_setprio(0); } while (0)
#define PG8_WAIT_V(n) asm volatile("s_waitcnt vmcnt(" #n ")" ::: "memory")
#define PG8_WAIT_L(n) asm volatile("s_waitcnt lgkmcnt(" #n ")" ::: "memory")
#define PG8_BAR __builtin_amdgcn_s_barrier()
#define PG8_SCHED __builtin_amdgcn_sched_barrier(0)
    Unit cur, nxt; int ui = 0;
    if (!S.next(0, cur)) return;
    f32x4 acc[2][2][4][2];
#pragma unroll
    for (int a = 0; a < 2; ++a)
#pragma unroll
        for (int b = 0; b < 2; ++b)
#pragma unroll
            for (int m = 0; m < 4; ++m)
#pragma unroll
                for (int n = 0; n < 2; ++n) acc[a][b][m][n] = (f32x4){0.f, 0.f, 0.f, 0.f};
    f16x8 At[4][2], B0[2][2], B1[2][2];
    const char* cA = (const char*)g.A + (size_t)cur.pm * tstep; const char* cB = (const char*)g.Bt + (size_t)cur.pn * tstep;
    PG8_STAGE(PG8_SB(0, 0), cB, voffB); PG8_STAGE(PG8_SB(0, 1), cB + bstep, voffB); mid(); PG8_STAGE(PG8_SA(0, 0), cA, voffA); PG8_STAGE(PG8_SA(0, 1), cA + hstep, voffA);
    pre();
    if (wr == 1) PG8_BAR;
    PG8_WAIT_V(2); PG8_BAR;
    PG8_STAGE(PG8_SB(1, 0), cB + kstep, voffB); PG8_STAGE(PG8_SA(1, 0), cA + kstep, voffA); PG8_STAGE(PG8_SB(1, 1), cB + bstep + kstep, voffB);
    PG8_WAIT_V(6); PG8_BAR;
    for (;;) {
        const bool has_next = S.next(ui + 1, nxt);
        const char* nA = has_next ? (const char*)g.A + (size_t)nxt.pm * tstep : cA; const char* nB = has_next ? (const char*)g.Bt + (size_t)nxt.pn * tstep : cB;
        int t = 0;
        if constexpr (PEEL) if (ui > 0) {
            const bool last = (t == nt - 2);
            if constexpr (Epi::MID) { if (t == nt / 2) E.mid(acc, cur, wr, wc, fr, fq); }
            const char* a1 = cA + (size_t)(t + 1) * kstep;
            const char* a2 = last ? nA : cA + (size_t)(t + 2) * kstep; const char* b2 = last ? nB : cB + (size_t)(t + 2) * kstep;
            const char* a3 = a2 + kstep; const char* b3 = b2 + kstep;
            PG8_LDB(B0, 0, 0); PG8_LDB(B1, 0, 1); PG8_SCHED; PG8_LDA(At, 0, 0); PG8_STAGE(PG8_SA(1, 1), a1 + hstep, voffA);
            PG8_WAIT_L(0); PG8_BAR; PG8_MMA(0, 0, At, B0); PG8_MMA(0, 1, At, B1); PG8_BAR; PG8_SCHED;
            PG8_LDA(At, 0, 1); PG8_STAGE(PG8_SB(0, 0), b2, voffB); PG8_STAGE(PG8_SB(0, 1), b2 + bstep, voffB); PG8_STAGE(PG8_SA(0, 0), a2, voffA);
            PG8_WAIT_L(0); PG8_BAR; PG8_MMA(1, 0, At, B0); PG8_MMA(1, 1, At, B1); PG8_BAR; PG8_SCHED;
            PG8_LDB(B0, 1, 0); PG8_LDB(B1, 1, 1); PG8_SCHED; PG8_LDA(At, 1, 0); PG8_STAGE(PG8_SA(0, 1), a2 + hstep, voffA);
            PG8_WAIT_V(8); PG8_WAIT_L(0); PG8_BAR; PG8_MMA(0, 0, At, B0); PG8_MMA(0, 1, At, B1); PG8_BAR; PG8_SCHED;
            PG8_LDA(At, 1, 1); PG8_STAGE(PG8_SB(1, 0), b3, voffB); PG8_STAGE(PG8_SB(1, 1), b3 + bstep, voffB); PG8_STAGE(PG8_SA(1, 0), a3, voffA);
            PG8_WAIT_V(8); PG8_WAIT_L(0); PG8_BAR; PG8_MMA(1, 0, At, B0); PG8_MMA(1, 1, At, B1); PG8_BAR; PG8_SCHED;
            t = 2;
        }
        for (; t < nt; t += 2) {
            const bool last = (t == nt - 2);
            if constexpr (Epi::MID) { if (t == nt / 2) E.mid(acc, cur, wr, wc, fr, fq); }
            const char* a1 = cA + (size_t)(t + 1) * kstep;
            const char* a2 = last ? nA : cA + (size_t)(t + 2) * kstep; const char* b2 = last ? nB : cB + (size_t)(t + 2) * kstep;
            const char* a3 = a2 + kstep; const char* b3 = b2 + kstep;
            PG8_LDB(B0, 0, 0); PG8_LDB(B1, 0, 1); PG8_SCHED; PG8_LDA(At, 0, 0); PG8_STAGE(PG8_SA(1, 1), a1 + hstep, voffA);
            PG8_WAIT_V(8); PG8_WAIT_L(0); PG8_BAR; PG8_MMA(0, 0, At, B0); PG8_MMA(0, 1, At, B1); PG8_BAR; PG8_SCHED;
            PG8_LDA(At, 0, 1); PG8_STAGE(PG8_SB(0, 0), b2, voffB); PG8_STAGE(PG8_SB(0, 1), b2 + bstep, voffB); PG8_STAGE(PG8_SA(0, 0), a2, voffA);
            PG8_WAIT_V(8); PG8_WAIT_L(0); PG8_BAR; PG8_MMA(1, 0, At, B0); PG8_MMA(1, 1, At, B1); PG8_BAR; PG8_SCHED;
            PG8_LDB(B0, 1, 0); PG8_LDB(B1, 1, 1); PG8_SCHED; PG8_LDA(At, 1, 0); PG8_STAGE(PG8_SA(0, 1), a2 + hstep, voffA);
            PG8_WAIT_V(8); PG8_WAIT_L(0); PG8_BAR; PG8_MMA(0, 0, At, B0); PG8_MMA(0, 1, At, B1); PG8_BAR; PG8_SCHED;
            PG8_LDA(At, 1, 1); PG8_STAGE(PG8_SB(1, 0), b3, voffB); PG8_STAGE(PG8_SB(1, 1), b3 + bstep, voffB); PG8_STAGE(PG8_SA(1, 0), a3, voffA);
            PG8_WAIT_V(8); PG8_WAIT_L(0); PG8_BAR; PG8_MMA(1, 0, At, B0); PG8_MMA(1, 1, At, B1); PG8_BAR; PG8_SCHED;
        }
        if constexpr (ALIGN_EPI) { if (wr == 0) PG8_BAR; }
        if constexpr (PEEL) { if (has_next) PG8_WAIT_V(0); }
        E(acc, cur, wr, wc, fr, fq);
        if (!has_next) break;
#pragma unroll
        for (int a = 0; a < 2; ++a)
#pragma unroll
            for (int b = 0; b < 2; ++b)
#pragma unroll
                for (int m = 0; m < 4; ++m)
#pragma unroll
                    for (int n = 0; n < 2; ++n) acc[a][b][m][n] = (f32x4){0.f, 0.f, 0.f, 0.f};
        cur = nxt; cA = nA; cB = nB; ++ui;
        if constexpr (ALIGN_EPI) { if (wr == 1) PG8_BAR; }
    }
    PG8_WAIT_V(0);
    if constexpr (!ALIGN_EPI) { if (wr == 0) PG8_BAR; }
    PG8_BAR;
#undef PG8_SA
#undef PG8_SB
#undef PG8_STAGE
#undef PG8_LDA
#undef PG8_LDB
#undef PG8_MMA
#undef PG8_WAIT_V
#undef PG8_WAIT_L
#undef PG8_BAR
#undef PG8_SCHED
}

__device__ __forceinline__ float sigmoidf_(float v) { return __builtin_amdgcn_rcpf(1.0f + __builtin_amdgcn_exp2f(-v * LOG2E)); }

struct EpiInProj {
    static constexpr bool MID = false;
    h16* bufs; h16* ga; h16* gb; const float* gtab; const float* bgate; const float* rope; float* kmean;
    __device__ __forceinline__ void operator()(f32x4 (&acc)[2][2][4][2], const Unit& u, int wr, int wc, int fr, int fq) const {
        const int l_ = lane_fresh(); fr = l_ & 15; fq = l_ >> 4;
        const int pn = u.pn;
        if (pn >= 16) {
            const int which = pn >= 20; unsigned char* g = (unsigned char*)(which ? gb : ga);
            const int pnl = pn - (which ? 20 : 16), colbase = pnl * 256 + 64 * wc + 8 * fq;
            f32x4 bv[2][2];
#pragma unroll
            for (int bj = 0; bj < 2; ++bj)
#pragma unroll
                for (int n = 0; n < 2; ++n) bv[bj][n] = *(const f32x4*)(bgate + which * 1024 + colbase + 32 * bj + 4 * n) * (-LOG2E) - 7.994353436858858f;
            const float qfloor = which ? 1.0f : 0.0f;
#pragma unroll
            for (int ai = 0; ai < 2; ++ai)
#pragma unroll
                for (int m = 0; m < 4; ++m) { const size_t row = (size_t)u.pm * 256 + 128 * ai + 64 * wr + 16 * m + fr; u32x4 w;
#pragma unroll
                    for (int bj = 0; bj < 2; ++bj)
#pragma unroll
                        for (int n = 0; n < 2; ++n) { unsigned pk = 0u;
#pragma unroll
                            for (int e = 0; e < 4; ++e) { const float ex = __builtin_amdgcn_exp2f(__builtin_fmaf(acc[ai][bj][m][n][e], -LOG2E, bv[bj][n][e]));
                                const float q = fmaxf(__builtin_amdgcn_rcpf(ex + 1.0f / 255.0f), qfloor); pk = __builtin_amdgcn_cvt_pk_u8_f32(q, e, pk); }
                            w[2 * bj + n] = pk; }
                    *(u32x4*)(g + row * 1024 + pnl * 256 + 64 * wc + 16 * fq) = w; __builtin_amdgcn_sched_barrier(0); }
            return;
        }
        const int grp = pn >> 1, head = 4 * (pn & 1) + wc, b = u.pm >> 4, blk = u.pm & 15;
        const bool do_norm = (grp == 0) | (grp == 1) | (grp == 4) | (grp == 5), do_rope = (grp == 4) | (grp == 5), do_silu = (grp == 3) | (grp == 7), do_kmean = (grp == 5);
        h16* dst = bufs + (size_t)grp * BUF_ELEMS + ((size_t)(b * NH + head) * SEQ) * HD + 8 * fq;
        const int tbase = blk * 256 + 64 * wr + fr;
        f32x4 gs[2][2];
        if (do_norm) { const float* gp = gtab + 64 * ((grp & 1) + ((grp >> 2) << 1));
#pragma unroll
            for (int bj = 0; bj < 2; ++bj)
#pragma unroll
                for (int n = 0; n < 2; ++n) gs[bj][n] = *(const f32x4*)(gp + 32 * bj + 8 * fq + 4 * n); }
        f32x4 cs[2][2];
#pragma unroll
        for (int bj = 0; bj < 2; ++bj)
#pragma unroll
            for (int n = 0; n < 2; ++n) cs[bj][n] = (f32x4){0.f, 0.f, 0.f, 0.f};
#pragma unroll
        for (int ai = 0; ai < 2; ++ai)
#pragma unroll
            for (int m = 0; m < 4; ++m) {
                const int t = tbase + 128 * ai + 16 * m;
                f32x4 v[2][2];
#pragma unroll
                for (int bj = 0; bj < 2; ++bj)
#pragma unroll
                    for (int n = 0; n < 2; ++n) v[bj][n] = acc[ai][bj][m][n];
                if (do_norm) {
                    float ss = 0.f;
#pragma unroll
                    for (int bj = 0; bj < 2; ++bj)
#pragma unroll
                        for (int n = 0; n < 2; ++n) { const f32x4 x = v[bj][n]; ss += (x[0] * x[0] + x[1] * x[1]) + (x[2] * x[2] + x[3] * x[3]); }
                    { auto p16 = __builtin_amdgcn_permlane16_swap(__float_as_uint(ss), __float_as_uint(ss), false, false); ss = __uint_as_float(p16[0]) + __uint_as_float(p16[1]);
                      auto p32 = __builtin_amdgcn_permlane32_swap(__float_as_uint(ss), __float_as_uint(ss), false, false); ss = __uint_as_float(p32[0]) + __uint_as_float(p32[1]); }
                    const float rstd = __builtin_amdgcn_rsqf(ss + 64.0f * RMS_EPS);
#pragma unroll
                    for (int bj = 0; bj < 2; ++bj)
#pragma unroll
                        for (int n = 0; n < 2; ++n) v[bj][n] = v[bj][n] * rstd * gs[bj][n];
                }
                if (do_rope) {
                    f32x4 pr[2];
#pragma unroll
                    for (int n = 0; n < 2; ++n)
#pragma unroll
                        for (int e = 0; e < 4; ++e) pr[n][e] = __int_as_float(__builtin_amdgcn_ds_bpermute((l_ ^ 16) << 2, __float_as_int(v[0][n][e])));
                    if (fq < 2) {
#pragma unroll
                        for (int n = 0; n < 2; ++n) { const f32x4 c = *(const f32x4*)(rope + t * 8 + 4 * n), s = *(const f32x4*)(rope + SEQ * 8 + t * 8 + 4 * n);
                            v[0][n] = (fq == 0) ? (v[0][n] * c - pr[n] * s) : (v[0][n] * c + pr[n] * s); }
                    }
                }
                if (do_kmean) {
#pragma unroll
                    for (int bj = 0; bj < 2; ++bj)
#pragma unroll
                        for (int n = 0; n < 2; ++n) cs[bj][n] += v[bj][n];
                }
                if (do_silu) {
#pragma unroll
                    for (int bj = 0; bj < 2; ++bj)
#pragma unroll
                        for (int n = 0; n < 2; ++n)
#pragma unroll
                            for (int e = 0; e < 4; ++e) v[bj][n][e] = v[bj][n][e] * __builtin_amdgcn_rcpf(1.0f + __builtin_amdgcn_exp2f(v[bj][n][e]));
                }
#pragma unroll
                for (int bj = 0; bj < 2; ++bj) { u32x4 w; w.x = cvt_pk_f16(v[bj][0][0], v[bj][0][1]); w.y = cvt_pk_f16(v[bj][0][2], v[bj][0][3]); w.z = cvt_pk_f16(v[bj][1][0], v[bj][1][1]); w.w = cvt_pk_f16(v[bj][1][2], v[bj][1][3]);
                    *(u32x4*)(dst + (size_t)t * HD + 32 * bj) = w; }
            }
        if (do_kmean) {
#pragma unroll
            for (int bj = 0; bj < 2; ++bj)
#pragma unroll
                for (int n = 0; n < 2; ++n)
#pragma unroll
                    for (int e = 0; e < 4; ++e) { float s = cs[bj][n][e];
#define DPPF_(x, ctrl) __int_as_float(__builtin_amdgcn_update_dpp(0, __float_as_int(x), ctrl, 0xF, 0xF, true))
                        s += DPPF_(s, 0xB1); s += DPPF_(s, 0x4E); s += DPPF_(s, 0x141); s += DPPF_(s, 0x140);
#undef DPPF_
                        if (fr == 0) atomicAdd(kmean + ((size_t)(b * NH + head) * 16 + blk) * HD + 32 * bj + 8 * fq + 4 * n + e, s * (1.0f / 256.0f)); }
        }
    }
};

struct EpiMerge {
    static constexpr bool MID = true;
    const unsigned char* __restrict__ ga; const unsigned char* __restrict__ gb; h16* __restrict__ out;
#define GATE_B(w, bj, n, e) ((float)(((w)[2 * (bj) + (n)] >> (8 * (e))) & 255u))
    __device__ __forceinline__ void mid(f32x4 (&acc)[2][2][4][2], const Unit& u, int wr, int wc, int fr, int fq) const {
        { const int l_ = lane_fresh(); fr = l_ & 15; fq = l_ >> 4; }
        const int col0 = u.pn * 256 + 64 * wc + 16 * fq;
#pragma unroll
        for (int ai = 0; ai < 2; ++ai) {
            u32x4 a[4], bb[4];
#pragma unroll
            for (int m = 0; m < 4; ++m) { const size_t row = (size_t)u.pm * 256 + 128 * ai + 64 * wr + 16 * m + fr;
                a[m] = __builtin_nontemporal_load((const u32x4*)(ga + row * 1024 + col0)); bb[m] = *(const u32x4*)(gb + row * 1024 + col0); }
            asm volatile("" ::: "memory");
#pragma unroll
            for (int m = 0; m < 4; ++m)
#pragma unroll
                for (int bj = 0; bj < 2; ++bj)
#pragma unroll
                    for (int n = 0; n < 2; ++n)
#pragma unroll
                        for (int e = 0; e < 4; ++e) acc[ai][bj][m][n][e] *= GATE_B(a[m], bj, n, e) * __builtin_amdgcn_rcpf(GATE_B(bb[m], bj, n, e));
            asm volatile("" ::: "memory"); }
    }
    __device__ __forceinline__ void operator()(f32x4 (&acc)[2][2][4][2], const Unit& u, int wr, int wc, int fr, int fq) const {
        { const int l_ = lane_fresh(); fr = l_ & 15; fq = l_ >> 4; }
        const int col0 = u.pn * 256 + 64 * wc;
        u32x4 bb[2][4];
#pragma unroll
        for (int ai = 0; ai < 2; ++ai)
#pragma unroll
            for (int m = 0; m < 4; ++m) { const size_t row = (size_t)u.pm * 256 + 128 * ai + 64 * wr + 16 * m + fr; bb[ai][m] = __builtin_nontemporal_load((const u32x4*)(gb + row * 1024 + col0 + 16 * fq)); }
        asm volatile("" ::: "memory");
        const float sc = 1.0f / 255.0f;
#pragma unroll
        for (int ai = 0; ai < 2; ++ai)
#pragma unroll
            for (int m = 0; m < 4; ++m) { const size_t row = (size_t)u.pm * 256 + 128 * ai + 64 * wr + 16 * m + fr;
#pragma unroll
                for (int bj = 0; bj < 2; ++bj) { const f32x4 v0 = acc[ai][bj][m][0] * sc, v1 = acc[ai][bj][m][1] * sc; u32x4 w;
                    w.x = cvt_pk_f16(v0[0] * GATE_B(bb[ai][m], bj, 0, 0), v0[1] * GATE_B(bb[ai][m], bj, 0, 1)); w.y = cvt_pk_f16(v0[2] * GATE_B(bb[ai][m], bj, 0, 2), v0[3] * GATE_B(bb[ai][m], bj, 0, 3));
                    w.z = cvt_pk_f16(v1[0] * GATE_B(bb[ai][m], bj, 1, 0), v1[1] * GATE_B(bb[ai][m], bj, 1, 1)); w.w = cvt_pk_f16(v1[2] * GATE_B(bb[ai][m], bj, 1, 2), v1[3] * GATE_B(bb[ai][m], bj, 1, 3));
                    *(u32x4*)(out + row * 1024 + col0 + 8 * fq + 32 * bj) = w; } }
    }
#undef GATE_B
};

struct EpiOut {
    static constexpr bool MID = false;
    const float* __restrict__ x; float* __restrict__ out; const h16* __restrict__ xn; const float* __restrict__ irs; const float* __restrict__ ng;
    __device__ __forceinline__ void operator()(f32x4 (&acc)[2][2][4][2], const Unit& u, int wr, int wc, int fr, int fq) const {
        { const int l_ = lane_fresh(); fr = l_ & 15; fq = l_ >> 4; }
        const int col0 = u.pn * 256 + 64 * wc + 8 * fq;
        f32x4 ig[2][2]; bool bad = false;
#pragma unroll
        for (int bj = 0; bj < 2; ++bj)
#pragma unroll
            for (int n = 0; n < 2; ++n) { const f32x4 g = *(const f32x4*)(ng + col0 + 32 * bj + 4 * n);
#pragma unroll
                for (int e = 0; e < 4; ++e) { bad |= !(fabsf(g[e]) >= 0.00390625f); ig[bj][n][e] = __builtin_amdgcn_rcpf(g[e]); } }
        if (!__any(bad)) {
            u32x4 xh[2][4][2]; float rs[2][4];
#pragma unroll
            for (int ai = 0; ai < 2; ++ai)
#pragma unroll
                for (int m = 0; m < 4; ++m) { const size_t row = (size_t)u.pm * 256 + 128 * ai + 64 * wr + 16 * m + fr; rs[ai][m] = __builtin_nontemporal_load(irs + row);
#pragma unroll
                    for (int bj = 0; bj < 2; ++bj) xh[ai][m][bj] = __builtin_nontemporal_load((const u32x4*)(xn + row * 1024 + col0 + 32 * bj)); }
            asm volatile("" ::: "memory");
#pragma unroll
            for (int ai = 0; ai < 2; ++ai)
#pragma unroll
                for (int m = 0; m < 4; ++m) { const size_t off = ((size_t)u.pm * 256 + 128 * ai + 64 * wr + 16 * m + fr) * 1024 + col0;
#pragma unroll
                    for (int bj = 0; bj < 2; ++bj) { const f16x8 hv = __builtin_bit_cast(f16x8, xh[ai][m][bj]);
#pragma unroll
                        for (int n = 0; n < 2; ++n) { f32x4 o;
#pragma unroll
                            for (int e = 0; e < 4; ++e) o[e] = __builtin_fmaf((float)hv[4 * n + e], rs[ai][m] * ig[bj][n][e], acc[ai][bj][m][n][e]);
                            *(f32x4*)(out + off + 32 * bj + 4 * n) = o; } } }
            asm volatile("" ::: "memory");
            return;
        }
#pragma unroll
        for (int ai = 0; ai < 2; ++ai) {
            f32x4 xv[4][2][2];
#pragma unroll
            for (int m = 0; m < 4; ++m) { const size_t off = ((size_t)u.pm * 256 + 128 * ai + 64 * wr + 16 * m + fr) * 1024 + col0;
#pragma unroll
                for (int bj = 0; bj < 2; ++bj)
#pragma unroll
                    for (int n = 0; n < 2; ++n) xv[m][bj][n] = *(const f32x4*)(x + off + 32 * bj + 4 * n); }
            asm volatile("" ::: "memory");
#pragma unroll
            for (int m = 0; m < 4; ++m) { const size_t off = ((size_t)u.pm * 256 + 128 * ai + 64 * wr + 16 * m + fr) * 1024 + col0;
#pragma unroll
                for (int bj = 0; bj < 2; ++bj)
#pragma unroll
                    for (int n = 0; n < 2; ++n) *(f32x4*)(out + off + 32 * bj + 4 * n) = xv[m][bj][n] + acc[ai][bj][m][n]; }
            asm volatile("" ::: "memory");
        }
    }
};
}

namespace fa {
constexpr int NW = 8, QBLK = 32, QB = 256, KVBLK = 64, PT = 64;
__device__ __forceinline__ int crow(int r, int hi) { return (r & 3) + 8 * (r >> 2) + 4 * hi; }
#define SBAR() __builtin_amdgcn_sched_barrier(0)
__device__ __forceinline__ void cmask(f32x16& p0, f32x16& p1, int jb, int qrel, int hi) {
    const float NEG = -INFINITY; int kb = 64 * jb + 4 * hi;
#pragma unroll
    for (int r = 0; r < 16; ++r) { int kv = kb + (r & 3) + 8 * (r >> 2); if (kv > qrel) p0[r] = NEG; if (kv + 32 > qrel) p1[r] = NEG; }
}
constexpr int NSLOT = 3, SLOTB = 8192;
constexpr int LDS_K = 0, LDS_V = NSLOT * SLOTB, LDS_WS = 2 * NSLOT * SLOTB, LDS_OST = LDS_WS + NW * 256 * 4, LDS_SEL = LDS_OST + NW * 4096, LDS_KM = LDS_SEL + 1024, LDS_END = LDS_KM + 4096;
__device__ __forceinline__ void glds16(const void* gsrc, unsigned lds_dst) { unsigned keep;
    asm volatile("s_mov_b32 %0, m0\n\ts_mov_b32 m0, %2\n\ts_nop 0\n\tglobal_load_lds_dwordx4 %1, off\n\ts_mov_b32 m0, %0" : "=&s"(keep) : "v"(gsrc), "s"(lds_dst) : "memory"); }
__device__ __forceinline__ void glds4(const void* gsrc, unsigned lds_dst) { unsigned keep;
    asm volatile("s_mov_b32 %0, m0\n\ts_mov_b32 m0, %2\n\ts_nop 0\n\tglobal_load_lds_dword %1, off\n\ts_mov_b32 m0, %0" : "=&s"(keep) : "v"(gsrc), "s"(lds_dst) : "memory"); }
__device__ __forceinline__ float max3f(float a, float b, float c) { float r; asm("v_max3_f32 %0, %1, %2, %3" : "=v"(r) : "v"(a), "v"(b), "v"(c)); return r; }
__device__ __forceinline__ float max2f(float a, float b) { float r; asm("v_max_f32_e32 %0, %1, %2" : "=v"(r) : "v"(a), "v"(b)); return r; }
__device__ __forceinline__ float fsub_s(float a, float b) { float r; asm("v_sub_f32_e32 %0, %1, %2" : "=v"(r) : "v"(a), "v"(b)); return r; }
__device__ __forceinline__ unsigned cvtpk_s(float lo, float hi) { f32x2 v = {lo, hi}; f16x2 b = __builtin_convertvector(v, f16x2); return __builtin_bit_cast(unsigned, b); }
#define WAIT_BAR(N) asm volatile("s_waitcnt vmcnt(" #N ") lgkmcnt(0)\n\ts_barrier" ::: "memory")
#define MFMA32(a, b, c) __builtin_amdgcn_mfma_f32_32x32x16_f16(a, b, c, 0, 0, 0)
typedef LAS const unsigned char* lds_cptr;
typedef short v4i16_t __attribute__((ext_vector_type(4)));
__device__ __forceinline__ void qkt(f32x16& p0, f32x16& p1, lds_cptr Kslot, const f16x8* qr, const f32x16& c0, const f32x16& c1, int r32, int hi) {
    lds_cptr kb = Kslot + hi * 1024 + r32 * 16;
#pragma unroll
    for (int d0 = 0; d0 < 4; ++d0) {
        const f16x8 b0 = *(const LAS f16x8*)(kb + d0 * 2048), b1 = *(const LAS f16x8*)(kb + d0 * 2048 + 512);
        if (d0 == 0) { p0 = MFMA32(b0, qr[0], c0); p1 = MFMA32(b1, qr[0], c1); }
        else { p0 = MFMA32(b0, qr[d0], p0); p1 = MFMA32(b1, qr[d0], p1); } }
}
__device__ __forceinline__ void kload8(f16x8* kf, lds_cptr kp) {
    kf[0] = *(const LAS f16x8*)(kp);        kf[1] = *(const LAS f16x8*)(kp + 512);
    kf[2] = *(const LAS f16x8*)(kp + 2048); kf[3] = *(const LAS f16x8*)(kp + 2560);
    kf[4] = *(const LAS f16x8*)(kp + 4096); kf[5] = *(const LAS f16x8*)(kp + 4608);
    kf[6] = *(const LAS f16x8*)(kp + 6144); kf[7] = *(const LAS f16x8*)(kp + 6656);
}
__device__ __forceinline__ void kload2(f16x8* kf, lds_cptr kp, int j) { kf[2 * j] = *(const LAS f16x8*)(kp + j * 2048); kf[2 * j + 1] = *(const LAS f16x8*)(kp + j * 2048 + 512); }
__device__ __forceinline__ s16x4 vtr(lds_cptr p) { return __builtin_bit_cast(s16x4, __builtin_amdgcn_ds_read_tr16_b64_v4i16((LAS v4i16_t*)p)); }
__device__ __forceinline__ float rowmax(const f32x16& p0, const f32x16& p1) {
    float a = max3f(p0[0], p0[1], p1[0]), b = max3f(p0[2], p0[3], p1[1]); a = max3f(a, p1[2], p1[3]);
#pragma unroll
    for (int r = 4; r < 16; r += 4) { a = max3f(a, p0[r], p0[r + 1]); b = max3f(b, p0[r + 2], p0[r + 3]); a = max3f(a, p1[r], p1[r + 1]); b = max3f(b, p1[r + 2], p1[r + 3]); }
    const float m = max2f(a, b);
    auto rr = __builtin_amdgcn_permlane32_swap(__float_as_uint(m), __float_as_uint(m), false, false);
    return max2f(__uint_as_float(rr[0]), __uint_as_float(rr[1]));
}
typedef short s16x8 __attribute__((ext_vector_type(8)));
#define F8(lo, hh) __builtin_bit_cast(f16x8, (s16x8){lo[0], lo[1], lo[2], lo[3], hh[0], hh[1], hh[2], hh[3]})
__device__ __forceinline__ void pv(f32x16* o, unsigned vb, f16x8 pa0, f16x8 pa1, f16x8 pa2, f16x8 pa3) {
#pragma unroll
    for (int d0 = 0; d0 < 2; ++d0) { s16x4 lo[4], hh[4];
#pragma unroll
        for (int ks = 0; ks < 4; ++ks) {
            asm volatile("ds_read_b64_tr_b16 %0,%1 offset:%c2" : "=&v"(lo[ks]) : "v"(vb), "i"(d0 * 4096 + ks * 1024) : "memory");
            asm volatile("ds_read_b64_tr_b16 %0,%1 offset:%c2" : "=&v"(hh[ks]) : "v"(vb), "i"(d0 * 4096 + ks * 1024 + 512) : "memory"); }
        asm volatile("s_waitcnt lgkmcnt(0)" ::: "memory"); SBAR();
        o[d0] = MFMA32(pa0, F8(lo[0], hh[0]), o[d0]);
        o[d0] = MFMA32(pa1, F8(lo[1], hh[1]), o[d0]);
        o[d0] = MFMA32(pa2, F8(lo[2], hh[2]), o[d0]);
        o[d0] = MFMA32(pa3, F8(lo[3], hh[3]), o[d0]);
    }
}

template <int TYPE, int THRL, bool FIXED>
__device__ __forceinline__ int attn_unit(LAS unsigned char* shm, int b, int h, int qb, const h16* Q, const h16* __restrict__ K, const h16* __restrict__ V, const h16* __restrict__ Zs, h16* Y,
                                         const float* __restrict__ cb2h, float cref2, int jstart, const float* __restrict__ kmeanh, float floor2,
                                         int rot0, const h16* nKt, const h16* nVt, const float* ncb1, int ntype) {
    int tid = threadIdx.x; asm volatile("" : "+v"(tid));
    const int lane = tid & 63, r32 = lane & 31, hi = lane >> 5; const int wid = __builtin_amdgcn_readfirstlane(tid >> 6);
    const size_t headoff = (size_t)(b * NH + h) * SEQ * HD; const int q0 = qb * QB;
    const h16* Qw = Q + headoff + (size_t)(q0 + wid * QBLK) * PT;
    const h16* Kh = K + headoff + (size_t)jstart * KVBLK * PT; const h16* Vh = V + headoff + (size_t)jstart * KVBLK * PT;
    const float* cbt = cb2h + jstart * KVBLK;
    const unsigned lds0 = (unsigned)(size_t)shm;
    LAS float* wsf = (LAS float*)(shm + LDS_WS) + wid * 256;
    unsigned selm = 0u;
    const h16* ksrc = Kh + (size_t)lane * PT + wid * 8;
    const h16* vsrc = Vh + (size_t)(16 * (wid & 3) + (lane >> 2)) * PT + (wid >> 2) * 32 + (lane & 3) * 8;
    const unsigned kdst = lds0 + LDS_K + wid * 1024, vdst = lds0 + LDS_V + wid * 1024;
#define DMA_K(t, slot) glds16(ksrc + (size_t)(t) * KVBLK * PT, (unsigned)__builtin_amdgcn_readfirstlane(kdst + (slot)))
#define DMA_V(t, slot) glds16(vsrc + (size_t)(t) * KVBLK * PT, (unsigned)__builtin_amdgcn_readfirstlane(vdst + (slot)))
#define DMA_B(t, line) glds4(cbt + (size_t)(t) * KVBLK + lane, (unsigned)__builtin_amdgcn_readfirstlane(lds0 + LDS_WS + wid * 1024 + 256 + (line) * 256))
    const unsigned vb0 = lds0 + LDS_V + ((lane >> 4) & 1) * 32 + (lane & 3) * 8 + (4 * hi + ((lane & 15) >> 2)) * 64;
    f16x8 kf[8];
    const lds_cptr kp0 = shm + LDS_K + hi * 1024 + r32 * 16; const lds_cptr vp0 = shm + LDS_V + ((lane >> 4) & 1) * 32 + (lane & 3) * 8 + (4 * hi + ((lane & 15) >> 2)) * 64;
    const int NT = (q0 + QB) / KVBLK - jstart;
#define NXTS(x) (((x) == (NSLOT - 1) * SLOTB) ? 0 : (x) + SLOTB)
    const int s0 = (rot0 < 0 ? 0 : rot0) * SLOTB, s1 = NXTS(s0), s2 = NXTS(s1);
    if (rot0 < 0) { DMA_K(0, s0); DMA_V(0, s0); DMA_K(1, s1); if (TYPE == 0) DMA_B(1, 1); }
    f16x8 qr[4];
#pragma unroll
    for (int d0 = 0; d0 < 4; ++d0) qr[d0] = *(const f16x8*)(Qw + (size_t)r32 * PT + d0 * 16 + hi * 8);
    if (TYPE == 1) {
        if (qb <= 3) selm = (2u << qb) - 1u;
        else {
            f32x16 gt = f32x16{};
#pragma unroll
            for (int d0 = 0; d0 < 4; ++d0) { f32x4 ka, kb;
                if (rot0 < 0) { const float* kp = kmeanh + (r32 & 15) * HD + 16 * d0 + 8 * hi; ka = *(const f32x4*)kp; kb = *(const f32x4*)(kp + 4); }
                else { const LAS float* kp = (const LAS float*)(shm + LDS_KM) + (r32 & 15) * HD + 16 * d0 + 8 * hi; ka = *(const LAS f32x4*)kp; kb = *(const LAS f32x4*)(kp + 4); }
                f16x8 kh, kl;
#pragma unroll
                for (int e = 0; e < 4; ++e) { const float va = (r32 < 16) ? ka[e] : 0.f, vb = (r32 < 16) ? kb[e] : 0.f; kh[e] = (h16)va; kh[4 + e] = (h16)vb; kl[e] = (h16)(va - (float)kh[e]); kl[4 + e] = (h16)(vb - (float)kh[4 + e]); }
                gt = MFMA32(kh, qr[d0], gt); gt = MFMA32(kl, qr[d0], gt); }
            float b0 = -INFINITY, b1 = -INFINITY, b2 = -INFINITY; int i0 = 0, i1 = 0, i2 = 0;
#pragma unroll
            for (int r = 0; r < 8; ++r) { const int n = (r & 3) + 8 * (r >> 2) + 4 * hi; const float gsum = (n < qb) ? gt[r] : -INFINITY;
                if (gsum > b0) { b2 = b1; i2 = i1; b1 = b0; i1 = i0; b0 = gsum; i0 = n; }
                else if (gsum > b1) { b2 = b1; i2 = i1; b1 = gsum; i1 = n; }
                else if (gsum > b2) { b2 = gsum; i2 = n; } }
            float c[6]; int ci[6];
            { auto r0 = __builtin_amdgcn_permlane32_swap(__float_as_uint(b0), __float_as_uint(b0), false, false); c[0] = __uint_as_float(r0[0]); c[3] = __uint_as_float(r0[1]);
              auto r1 = __builtin_amdgcn_permlane32_swap(__float_as_uint(b1), __float_as_uint(b1), false, false); c[1] = __uint_as_float(r1[0]); c[4] = __uint_as_float(r1[1]);
              auto r2 = __builtin_amdgcn_permlane32_swap(__float_as_uint(b2), __float_as_uint(b2), false, false); c[2] = __uint_as_float(r2[0]); c[5] = __uint_as_float(r2[1]);
              auto j0 = __builtin_amdgcn_permlane32_swap((unsigned)i0, (unsigned)i0, false, false); ci[0] = (int)j0[0]; ci[3] = (int)j0[1];
              auto j1 = __builtin_amdgcn_permlane32_swap((unsigned)i1, (unsigned)i1, false, false); ci[1] = (int)j1[0]; ci[4] = (int)j1[1];
              auto j2 = __builtin_amdgcn_permlane32_swap((unsigned)i2, (unsigned)i2, false, false); ci[2] = (int)j2[0]; ci[5] = (int)j2[1]; }
            float m0 = -INFINITY, m1 = -INFINITY, m2 = -INFINITY; int k0 = 0, k1 = 0, k2 = 0;
#pragma unroll
            for (int q = 0; q < 6; ++q) { const float gsum = c[q]; const int n = ci[q];
                if (gsum > m0 || (gsum == m0 && n < k0)) { m2 = m1; k2 = k1; m1 = m0; k1 = k0; m0 = gsum; k0 = n; }
                else if (gsum > m1 || (gsum == m1 && n < k1)) { m2 = m1; k2 = k1; m1 = gsum; k1 = n; }
                else if (gsum > m2 || (gsum == m2 && n < k2)) { m2 = gsum; k2 = n; } }
            selm = (1u << k0) | (1u << k1) | (1u << k2) | (1u << qb);
        }
    }
    float mhat = 0.f, l_reg = 0.f; f32x16 o[2]; o[0] = f32x16{}; o[1] = f32x16{};
    float nm = 0.f;
    f32x16 negm = f32x16{}; asm volatile("" : "+v"(negm));
#define NEGM_SET() do { _Pragma("unroll") for (int r = 0; r < 16; ++r) negm[r] = nm; asm volatile("" : "+v"(negm)); } while (0)
    float cm = 0.f;
    const int qrel = wid * QBLK + r32;
    f32x16 pA0, pA1, pB0, pB1;
    if (TYPE == 0) {
#pragma unroll
        for (int g4 = 0; g4 < 4; ++g4) { const f32x4 c0 = *(const f32x4*)(cbt + 8 * g4 + 4 * hi), c1 = *(const f32x4*)(cbt + 32 + 8 * g4 + 4 * hi);
#pragma unroll
            for (int e = 0; e < 4; ++e) { pA0[4 * g4 + e] = c0[e] + cref2; pA1[4 * g4 + e] = c1[e] + cref2; } }
    }
#define CMASK(P0, P1, t) do { int jb_ = (t) - (NT - 4); if (jb_ >= 0) cmask(P0, P1, jb_, qrel, hi); } while (0)
    bool resc = false;
    bool cur_sel = true;
    if (TYPE == 1) { cur_sel = (selm & 1u) != 0u; nm = cur_sel ? 0.f : -INFINITY;
#pragma unroll
        for (int r = 0; r < 16; ++r) { pA0[r] = nm; pA1[r] = nm; } }
#define RESC() do { if (resc) { asm volatile("s_waitcnt lgkmcnt(0)" ::: "memory"); \
      _Pragma("unroll") for (int d_ = 0; d_ < 2; ++d_) _Pragma("unroll") for (int r = 0; r < 16; ++r) o[d_][r] *= wsf[crow(r, hi)]; } } while (0)
    int sl_prev = s0, sl_cur = s0, sl_next = s1;
#define ROT() do { sl_prev = sl_cur; sl_cur = sl_next; sl_next = (sl_next == (NSLOT - 1) * SLOTB) ? 0 : sl_next + SLOTB; } while (0)
    if (rot0 < 0) DMA_K(2, s2);
    WAIT_BAR(3);
    qkt(pA0, pA1, shm + LDS_K + s0, qr, pA0, pA1, r32, hi);
    asm volatile("s_nop 15\n\ts_nop 7" : "+v"(pA0), "+v"(pA1)); CMASK(pA0, pA1, 0);
    { resc = false;
      const float dl = FIXED ? (-floor2 - 15.0f) : (TYPE == 0) ? (cref2 + cbt[(q0 - jstart * KVBLK) + wid * QBLK + r32]) : fmaxf(rowmax(pA0, pA1), floor2); mhat = dl;
#pragma unroll
      for (int r = 0; r < 16; ++r) { pA0[r] = fsub_s(pA0[r], dl); pA1[r] = fsub_s(pA1[r], dl); }
      if (TYPE == 0) cm = cref2 - mhat;
      else { nm = cur_sel ? -mhat : -INFINITY; NEGM_SET(); }
#pragma unroll
      for (int r = 0; r < 16; ++r) pA0[r] = __builtin_amdgcn_exp2f(pA0[r]); }
#pragma unroll
    for (int r = 0; r < 16; ++r) pA1[r] = __builtin_amdgcn_exp2f(pA1[r]);
    WAIT_BAR(0);
    DMA_K(3, s0); DMA_V(1, s1);
    ROT();
    kload8(kf, kp0 + sl_cur);
    WAIT_BAR(2);
    s16x4 vlo[8], vhi[8]; u32x4 pw0, pw1, pw2, pw3;
#define PKW(P, B) cvtpk_s(P[B], P[B + 1])
#define PAF(k) __builtin_bit_cast(f16x8, pw##k)
#define VFR(i) F8(vlo[i], vhi[i])
#define PIN(x) asm volatile("" : "+v"(x))
#define MX3(a, b, c) __builtin_fmaxf(__builtin_fmaxf((a), (b)), (c))
#define GAPA(MF, A0, A1, A2, A3, W0, W1, PW) do { MF; sacc += A0; sacc += A1; sacc += A2; sacc += A3; PIN(sacc); W0; W1; PIN(PW); SBAR(); } while (0)
#define EX(v) __builtin_amdgcn_exp2f(v)
#define GAPB(MF, X, B) do { MF; X[B] = EX(X[B]); X[B + 1] = EX(X[B + 1]); X[B + 2] = EX(X[B + 2]); X[B + 3] = EX(X[B + 3]); PIN(X); SBAR(); } while (0)
#define VRD(i) do { vlo[i] = vtr(vp_ + (((i) >> 2) * 4096 + ((i) & 3) * 1024)); vhi[i] = vtr(vp_ + (((i) >> 2) * 4096 + ((i) & 3) * 1024 + 512)); } while (0)
#define KRD(G, j) do { if (G) { kload2(kf, kp0 + sl_next, j); SBAR(); } } while (0)
#define CINIT(C0, C1, t, GB, LN) do { \
    if (TYPE == 0) { \
        _Pragma("unroll") for (int g4 = 0; g4 < 4; ++g4) { const f32x4 c0_ = *(const LAS f32x4*)(wsf + 64 + (LN) * 64 + 8 * g4 + 4 * hi), c1_ = *(const LAS f32x4*)(wsf + 96 + (LN) * 64 + 8 * g4 + 4 * hi); \
            _Pragma("unroll") for (int e = 0; e < 4; ++e) { C0[4 * g4 + e] = c0_[e] + cm; C1[4 * g4 + e] = c1_[e] + cm; } } \
        if (GB) { DMA_B((t) + 1, 1 - (LN)); } \
    } else { \
        if ((((t) + jstart) & 3) == 0) { const int jb2_ = ((t) + jstart) >> 2; cur_sel = ((selm >> jb2_) & 1u) != 0u; nm = cur_sel ? -mhat : -INFINITY; NEGM_SET(); } \
    } } while (0)
#define STEP(C0, C1, P0, P1, t, GK, GV, GL, LN) do { SBAR(); \
    CINIT(C0, C1, t, GL, LN); SBAR(); \
    const lds_cptr vp_ = vp0 + sl_prev; \
    VRD(0); SBAR(); float sacc = (P0[0] + P0[1]); __builtin_amdgcn_s_setprio(1);   \
    if (TYPE == 0) { \
    GAPA(C0 = MFMA32(kf[0], qr[0], C0), P0[2], P0[3], P0[4], P0[5],     pw0[0] = PKW(P0, 0), pw0[1] = PKW(P0, 2), pw0); \
    VRD(4); SBAR(); GAPA(C1 = MFMA32(kf[1], qr[0], C1), P0[6], P0[7], P0[8], P0[9],     pw0[2] = PKW(P0, 4), pw0[3] = PKW(P0, 6), pw0); \
    } else { \
    GAPA(C0 = MFMA32(kf[0], qr[0], negm), P0[2], P0[3], P0[4], P0[5],     pw0[0] = PKW(P0, 0), pw0[1] = PKW(P0, 2), pw0); \
    VRD(4); SBAR(); GAPA(C1 = MFMA32(kf[1], qr[0], negm), P0[6], P0[7], P0[8], P0[9],     pw0[2] = PKW(P0, 4), pw0[3] = PKW(P0, 6), pw0); \
    } \
    VRD(1); SBAR(); GAPA(C0 = MFMA32(kf[2], qr[1], C0),   P0[10], P0[11], P0[12], P0[13], pw1[0] = PKW(P0, 8), pw1[1] = PKW(P0, 10), pw1); \
    VRD(5); SBAR(); GAPA(C1 = MFMA32(kf[3], qr[1], C1),   P0[14], P0[15], P1[0], P1[1],   pw1[2] = PKW(P0, 12), pw1[3] = PKW(P0, 14), pw1); \
    VRD(2); SBAR(); GAPA(C0 = MFMA32(kf[4], qr[2], C0),   P1[2], P1[3], P1[4], P1[5],     pw2[0] = PKW(P1, 0), pw2[1] = PKW(P1, 2), pw2); \
    VRD(6); SBAR(); GAPA(C1 = MFMA32(kf[5], qr[2], C1),   P1[6], P1[7], P1[8], P1[9],     pw2[2] = PKW(P1, 4), pw2[3] = PKW(P1, 6), pw2); \
    VRD(3); SBAR(); GAPA(C0 = MFMA32(kf[6], qr[3], C0),   P1[10], P1[11], P1[12], P1[13], pw3[0] = PKW(P1, 8), pw3[1] = PKW(P1, 10), pw3); \
    VRD(7); SBAR(); GAPA(C1 = MFMA32(kf[7], qr[3], C1),   P1[14], P1[15], 0.f, 0.f,       pw3[2] = PKW(P1, 12), pw3[3] = PKW(P1, 14), pw3); \
    __builtin_amdgcn_s_setprio(0); l_reg += sacc; \
    if (GK) { DMA_K((t) + 3, sl_cur); } if (GV) { DMA_V((t) + 1, sl_next); } \
    CMASK(C0, C1, t); \
    resc = false; \
      \
    if (!FIXED && (TYPE != 0 || (floor2 > (float)THRL && __any(floor2 + wsf[64 + (LN) * 64 + 63] + cm > (float)THRL)))) { float a = MX3(C0[0], C0[1], C1[0]), b_ = MX3(C0[2], C0[3], C1[1]); a = MX3(a, C1[2], C1[3]); \
      _Pragma("unroll") for (int r = 4; r < 16; r += 4) { a = MX3(a, C0[r], C0[r + 1]); b_ = MX3(b_, C0[r + 2], C0[r + 3]); a = MX3(a, C1[r], C1[r + 1]); b_ = MX3(b_, C1[r + 2], C1[r + 3]); } \
      float rm = __builtin_fmaxf(a, b_); { auto rr = __builtin_amdgcn_permlane32_swap(__float_as_uint(rm), __float_as_uint(rm), false, false); rm = __builtin_fmaxf(__uint_as_float(rr[0]), __uint_as_float(rr[1])); } \
      resc = false; \
      if (__builtin_expect(__any(rm > (float)THRL), 0)) { const float dl = __builtin_fmaxf(rm, 0.f); mhat += dl; \
        _Pragma("unroll") for (int r = 0; r < 16; ++r) { C0[r] -= dl; C1[r] -= dl; } \
        if (TYPE == 0) cm = cref2 - mhat; \
        else { nm = cur_sel ? -mhat : -INFINITY; NEGM_SET(); } \
        const float f = __builtin_amdgcn_exp2f(-dl); l_reg *= f; if (hi == 0) wsf[r32] = f; resc = true; } } \
    SBAR(); __builtin_amdgcn_s_setprio(1); \
    GAPB(o[0] = MFMA32(PAF(0), VFR(0), o[0]), C0, 0); \
    GAPB(o[1] = MFMA32(PAF(0), VFR(4), o[1]), C0, 4); \
    KRD(GL, 0); GAPB(o[0] = MFMA32(PAF(1), VFR(1), o[0]), C0, 8); \
    KRD(GL, 1); GAPB(o[1] = MFMA32(PAF(1), VFR(5), o[1]), C0, 12); \
    KRD(GL, 2); GAPB(o[0] = MFMA32(PAF(2), VFR(2), o[0]), C1, 0); \
    KRD(GL, 3); GAPB(o[1] = MFMA32(PAF(2), VFR(6), o[1]), C1, 4); \
    GAPB(o[0] = MFMA32(PAF(3), VFR(3), o[0]), C1, 8); \
    GAPB(o[1] = MFMA32(PAF(3), VFR(7), o[1]), C1, 12); __builtin_amdgcn_s_setprio(0); \
    } while (0)
    int t = 1;
#undef CMASK
#define CMASK(P0, P1, t) do { } while (0)
    for (; t + 5 < NT; t += 2) {
        STEP(pB0, pB1, pA0, pA1, t, true, true, true, 1);     WAIT_BAR(2); RESC(); ROT();
        STEP(pA0, pA1, pB0, pB1, t + 1, true, true, true, 0); WAIT_BAR(2); RESC(); ROT();
    }
#undef CMASK
#define CMASK(P0, P1, t) do { int jb_ = (t) - (NT - 4); if (jb_ >= 0) cmask(P0, P1, jb_, qrel, hi); } while (0)
#define ENDW(tt) do { if ((tt) + 3 < NT) { WAIT_BAR(2); } else if ((tt) + 2 < NT) { WAIT_BAR(1); } else { WAIT_BAR(0); } } while (0)
    for (; t + 1 < NT; t += 2) {
        STEP(pB0, pB1, pA0, pA1, t, (t + 3 < NT), (t + 1 < NT), (t + 1 < NT), 1);         ENDW(t);     RESC(); ROT();
        STEP(pA0, pA1, pB0, pB1, t + 1, (t + 4 < NT), (t + 2 < NT), (t + 2 < NT), 0);     ENDW(t + 1); RESC(); ROT();
    }
    STEP(pB0, pB1, pA0, pA1, NT - 1, false, false, false, 1); RESC();
    u32x4 zq0, zq1, zq2, zq3; int rotn = -1;
    { const h16* Zw_ = Zs + headoff + (size_t)(q0 + wid * QBLK + (lane >> 3)) * PT + (lane & 7) * 8;
      asm volatile("global_load_dwordx4 %0, %1, off" : "=v"(zq0) : "v"(Zw_) : "memory");
      asm volatile("global_load_dwordx4 %0, %1, off" : "=v"(zq1) : "v"(Zw_ + 8 * PT) : "memory");
      asm volatile("global_load_dwordx4 %0, %1, off" : "=v"(zq2) : "v"(Zw_ + 16 * PT) : "memory");
      asm volatile("global_load_dwordx4 %0, %1, off" : "=v"(zq3) : "v"(Zw_ + 24 * PT) : "memory"); }
    if (ntype >= 0) { rotn = sl_next / SLOTB; const int a0 = sl_next, a1 = NXTS(a0), a2 = NXTS(a1);
        const h16* nks = nKt + (size_t)lane * PT + wid * 8; const h16* nvs = nVt + (size_t)(16 * (wid & 3) + (lane >> 2)) * PT + (wid >> 2) * 32 + (lane & 3) * 8;
        glds16(nks, (unsigned)__builtin_amdgcn_readfirstlane(kdst + a0)); glds16(nvs, (unsigned)__builtin_amdgcn_readfirstlane(vdst + a0));
        glds16(nks + (size_t)KVBLK * PT, (unsigned)__builtin_amdgcn_readfirstlane(kdst + a1));
        if (ntype == 0) glds4(ncb1 + lane, (unsigned)__builtin_amdgcn_readfirstlane(lds0 + LDS_WS + wid * 1024 + 256 + 256));
        glds16(nks + (size_t)2 * KVBLK * PT, (unsigned)__builtin_amdgcn_readfirstlane(kdst + a2)); }
    { float sacc = pB0[0] + pB0[1];
#pragma unroll
      for (int r = 2; r < 16; ++r) sacc += pB0[r];
#pragma unroll
      for (int r = 0; r < 16; ++r) sacc += pB1[r];
      l_reg += sacc;
      pw0 = (u32x4){PKW(pB0, 0), PKW(pB0, 2), PKW(pB0, 4), PKW(pB0, 6)}; pw1 = (u32x4){PKW(pB0, 8), PKW(pB0, 10), PKW(pB0, 12), PKW(pB0, 14)};
      pw2 = (u32x4){PKW(pB1, 0), PKW(pB1, 2), PKW(pB1, 4), PKW(pB1, 6)}; pw3 = (u32x4){PKW(pB1, 8), PKW(pB1, 10), PKW(pB1, 12), PKW(pB1, 14)};
      SBAR(); pv(o, vb0 + sl_cur, PAF(0), PAF(1), PAF(2), PAF(3)); }
#undef PKW
#undef PAF
#undef VFR
#undef PIN
#undef MX3
#undef GAPA
#undef GAPB
#undef EX
#undef VRD
#undef KRD
#undef STEP
#undef ENDW
#undef CINIT
    { auto rr = __builtin_amdgcn_permlane32_swap(__float_as_uint(l_reg), __float_as_uint(l_reg), false, false); l_reg = __uint_as_float(rr[0]) + __uint_as_float(rr[1]); }
    if (hi == 0) wsf[32 + r32] = l_reg; asm volatile("s_waitcnt lgkmcnt(0)" ::: "memory");
    float rli[16];
#pragma unroll
    for (int r = 0; r < 16; ++r) rli[r] = __builtin_amdgcn_rcpf(wsf[32 + crow(r, hi)] * -LOG2E);
    { LAS h16* stg = (LAS h16*)(shm + LDS_OST) + wid * 2048;
      int le = lane; asm volatile("" : "+v"(le));
      const int r32e = le & 31, hie = le >> 5;
#pragma unroll
      for (int r = 0; r < 16; ++r) { const int orow = crow(r, hie);
#pragma unroll
          for (int d0 = 0; d0 < 2; ++d0) stg[orow * 64 + d0 * 32 + r32e] = (h16)(o[d0][r] * rli[r]); }
      asm volatile("s_waitcnt lgkmcnt(0)" ::: "memory");
      h16* Yw = Y + ((size_t)b * SEQ + q0 + wid * QBLK) * 1024 + TYPE * 512 + h * HD;
      if (ntype == 0) asm volatile("s_waitcnt vmcnt(5)" : "+v"(zq0), "+v"(zq1), "+v"(zq2), "+v"(zq3) :: "memory");
      else if (ntype == 1) asm volatile("s_waitcnt vmcnt(4)" : "+v"(zq0), "+v"(zq1), "+v"(zq2), "+v"(zq3) :: "memory");
      else asm volatile("s_waitcnt vmcnt(0)" : "+v"(zq0), "+v"(zq1), "+v"(zq2), "+v"(zq3) :: "memory");
      f16x8 zq[4] = {__builtin_bit_cast(f16x8, zq0), __builtin_bit_cast(f16x8, zq1), __builtin_bit_cast(f16x8, zq2), __builtin_bit_cast(f16x8, zq3)};
#pragma unroll
      for (int i = 0; i < 4; ++i) { const int row = i * 8 + (le >> 3), ch = le & 7; const f16x8 ov = *(const LAS f16x8*)(stg + row * 64 + ch * 8);
          const f16x8 zv = zq[i];
          u32x4 w; w.x = cvtpk_s((float)ov[0] * (float)zv[0], (float)ov[1] * (float)zv[1]); w.y = cvtpk_s((float)ov[2] * (float)zv[2], (float)ov[3] * (float)zv[3]);
          w.z = cvtpk_s((float)ov[4] * (float)zv[4], (float)ov[5] * (float)zv[5]); w.w = cvtpk_s((float)ov[6] * (float)zv[6], (float)ov[7] * (float)zv[7]);
          *(u32x4*)(Yw + (size_t)row * 1024 + ch * 8) = w; } }
    asm volatile("s_waitcnt lgkmcnt(0)\n\ts_barrier" ::: "memory");
    return rotn;
#undef NXTS
#undef NEGM_SET
#undef DMA_K
#undef DMA_V
#undef DMA_B
#undef CMASK
#undef RESC
#undef ROT
}
#undef SBAR
#undef WAIT_BAR
#undef MFMA32
#undef F8
}

#define GAS __attribute__((address_space(1)))
typedef GAS unsigned gu32;
#define RLX_AGENT __ATOMIC_RELAXED, __HIP_MEMORY_SCOPE_AGENT
#define XB_TMO      128
#define XB_XCNT(j)  (256  + 64 * (j))
#define XB_XSUB(j)  (1280 + 64 * (j))
#define XB_XGEN(j)  (2304 + 64 * (j))
#define XB_TOP      3328
#define XB_TOPGEN   3392
#define XCD_BAR_WORDS 3456
#define XB_SPIN_CAP (1u << 18)

__device__ __forceinline__ unsigned xb_ld(unsigned* p)              { return __hip_atomic_load(p, __ATOMIC_RELAXED, __HIP_MEMORY_SCOPE_AGENT); }
__device__ __forceinline__ unsigned xb_add(unsigned* p, unsigned v) { return __hip_atomic_fetch_add(p, v, __ATOMIC_RELAXED, __HIP_MEMORY_SCOPE_AGENT); }
__device__ __forceinline__ unsigned xb_xcc_id() { return (unsigned)__builtin_amdgcn_s_getreg((3 << 11) | 20) & 0xFu; }
#define XB_SPIN(cond, bar) do { unsigned _sp = 0; while (cond) { __builtin_amdgcn_s_sleep(1); \
    if ((++_sp & 255u) == 0u) { if (xb_ld(&(bar)[XB_TMO])) break; if (_sp > XB_SPIN_CAP) { atomicAdd(&(bar)[XB_TMO], 1u); break; } } } } while (0)

struct XcdBarrier {
    unsigned* bar; unsigned x;
    volatile LAS unsigned* st;
};

__device__ __forceinline__ XcdBarrier xcd_barrier_post(unsigned* bar, volatile LAS unsigned* st) {
    XcdBarrier b; b.bar = bar; b.x = xb_xcc_id(); b.st = st;
    if (threadIdx.x == 0) st[4] = xb_add(&bar[XB_XCNT(b.x)], 1u) + 1u;
    return b;
}
__device__ __forceinline__ void xcd_barrier_complete(unsigned* bar, unsigned x, unsigned& nloc, unsigned& nx, unsigned& uni) {
    const unsigned G = gridDim.x * gridDim.y * gridDim.z;
    unsigned sum, cnt, mine, full, sp = 0u;
    for (;;) {
        sum = 0u; cnt = 0u; mine = 0u; full = 0u;
#pragma unroll
        for (unsigned j = 0; j < 16; ++j) { const unsigned c = xb_ld(&bar[XB_XCNT(j)]); sum += c; cnt += (c > 0u) ? 1u : 0u; mine = (j == x) ? c : mine; full += (j < 8u && c == 32u) ? 1u : 0u; }
        if (sum == G) break;
        __builtin_amdgcn_s_sleep(1);
        if ((++sp & 255u) == 0u) { if (xb_ld(&bar[XB_TMO])) break; if (sp > XB_SPIN_CAP) { atomicAdd(&bar[XB_TMO], 1u); break; } }
    }
    nloc = mine > 0u ? mine : 1u; nx = cnt > 0u ? cnt : 1u;
    uni = (sum == G && G == 256u && full == 8u) ? 1u : 2u;
}

template <bool NL_INV = true>
__device__ __forceinline__ void xcd_barrier(const XcdBarrier& b) {
    asm volatile("s_waitcnt vmcnt(0)" ::: "memory");
    __syncthreads();
    if (threadIdx.x == 0) {
        unsigned* bar = b.bar;
        __builtin_amdgcn_s_waitcnt(0);
        unsigned nloc = b.st[0], nx = b.st[1];
        if (nloc == 0u) { unsigned uni; xcd_barrier_complete(bar, b.x, nloc, nx, uni); b.st[0] = nloc; b.st[1] = nx; b.st[2] = uni; }
        const unsigned old = xb_add(&bar[XB_XSUB(b.x)], 1u);
        const unsigned gen = old / nloc;
        if (old + 1u == (gen + 1u) * nloc) {
            __builtin_amdgcn_fence(__ATOMIC_RELEASE, "agent");
            asm volatile("s_waitcnt vmcnt(0)" ::: "memory");
            const unsigned og = xb_add(&bar[XB_TOP], 1u);
            const unsigned tg = og / nx;
            if (og + 1u == (tg + 1u) * nx) xb_add(&bar[XB_TOPGEN], 1u);
            else XB_SPIN(xb_ld(&bar[XB_TOPGEN]) == tg, bar);
            __builtin_amdgcn_fence(__ATOMIC_ACQUIRE, "agent");
            if constexpr (!NL_INV) asm volatile("s_waitcnt vmcnt(0)" ::: "memory");
            xb_add(&bar[XB_XGEN(b.x)], 1u);
            asm volatile("s_waitcnt vmcnt(0)" ::: "memory");
        } else {
            XB_SPIN(xb_ld(&bar[XB_XGEN(b.x)]) == gen, bar);
            if constexpr (NL_INV) __builtin_amdgcn_fence(__ATOMIC_ACQUIRE, "agent"); else asm volatile("" ::: "memory");
            asm volatile("s_waitcnt vmcnt(0)" ::: "memory");
        }
    }
    __syncthreads();
}

struct SeamWait { unsigned* fl; unsigned* barw; bool on;
    __device__ __forceinline__ void operator()() const { if (on) { if (threadIdx.x == 0) { XB_SPIN(xb_ld(fl) < 4u, barw); } asm volatile("" ::: "memory"); __builtin_amdgcn_s_barrier(); asm volatile("" ::: "memory"); } } };

__device__ __forceinline__ float wave_sum(float v) {
#pragma unroll
    for (int o = 1; o < 64; o <<= 1) v += __shfl_xor(v, o);
    return v;
}
template <bool ZSC = false>
__device__ __forceinline__ void p0_transpose_item(const float* W, int ldw, h16* WT, int ldt, int nblk, LAS float* scr, int item, int lane) {
    const int kb = item / nblk, nb = item % nblk, k0 = 64 * kb, n0 = 32 * nb;
    const float wsc = (ZSC && n0 < 4096 && (((n0 >> 9) & 3) == 3)) ? -LOG2E : 1.0f;
#pragma unroll
    for (int i = 0; i < 8; ++i) { const int kk = 8 * i + (lane >> 3), nn = 4 * (lane & 7);
        const f32x4 w4 = __builtin_nontemporal_load((const f32x4*)(W + (size_t)(k0 + kk) * ldw + n0 + nn)) * wsc;
        LAS float* d = scr + kk * 33 + nn; d[0] = w4[0]; d[1] = w4[1]; d[2] = w4[2]; d[3] = w4[3]; }
    asm volatile("s_waitcnt lgkmcnt(0)" ::: "memory");
    const int c = lane & 7;
#pragma unroll
    for (int j = 0; j < 4; ++j) { const int n = (lane >> 3) + 8 * j; const LAS float* s = scr + (8 * c) * 33 + n;
        u32x4 o; o.x = pg8::cvt_pk_f16(s[0 * 33], s[1 * 33]); o.y = pg8::cvt_pk_f16(s[2 * 33], s[3 * 33]); o.z = pg8::cvt_pk_f16(s[4 * 33], s[5 * 33]); o.w = pg8::cvt_pk_f16(s[6 * 33], s[7 * 33]);
        *(u32x4*)(WT + (size_t)(n0 + n) * ldt + k0 + 8 * c) = o; }
    asm volatile("s_waitcnt lgkmcnt(0)" ::: "memory");
}
__device__ __forceinline__ void sincos_d(double a, double& s, double& c) {
    const double kq = rint(a * 0.63661977236758134308);
    double r = fma(-kq, 1.57079632679489655800e+00, a); r = fma(-kq, 6.12323399573676603587e-17, r);
    const int q = ((int)kq) & 3; const double r2 = r * r;
    const double sp = r * (1.0 + r2 * (-1.0 / 6 + r2 * (1.0 / 120 + r2 * (-1.0 / 5040 + r2 * (1.0 / 362880 + r2 * (-1.0 / 39916800 + r2 * (1.0 / 6227020800.0 + r2 * (-1.0 / 1307674368000.0))))))));
    const double cp = 1.0 + r2 * (-0.5 + r2 * (1.0 / 24 + r2 * (-1.0 / 720 + r2 * (1.0 / 40320 + r2 * (-1.0 / 3628800 + r2 * (1.0 / 479001600 + r2 * (-1.0 / 87178291200.0 + r2 * (1.0 / 20922789888000.0))))))));
    s = (q == 0) ? sp : (q == 1) ? cp : (q == 2) ? -sp : -cp;
    c = (q == 0) ? cp : (q == 1) ? -sp : (q == 2) ? -cp : sp;
}

#define XPREF 1
struct Args { const float* in[12]; float* out; unsigned char* ws; int ph_lo, ph_hi; };

__global__ void __launch_bounds__(NWAVES * 64, 2) fwd(Args args) {
    extern __shared__ __attribute__((aligned(16))) unsigned char lds_raw[];
    LAS unsigned char* lds = (LAS unsigned char*)lds_raw;
    const int tid = threadIdx.x, lane = tid & 63, wave = __builtin_amdgcn_readfirstlane(tid >> 6);
    const int G = gridDim.x; const int bx = blockIdx.x; const int vcu = (G % 8 == 0) ? (bx % 8) * (G / 8) + bx / 8 : bx;
    unsigned char* ws = args.ws;
    volatile LAS unsigned* MISC = (volatile LAS unsigned*)(lds + RING_BYTES);
    if (tid < 32) MISC[tid] = 0u;
    __syncthreads();
    XcdBarrier bar = xcd_barrier_post((unsigned*)(ws + WS_CTL) + 1024, MISC + 8);
    const float* x = args.in[0]; const float* norm_g = args.in[1]; const float* w_in = args.in[2]; const float* b_f = args.in[3]; const float* b_gate = args.in[4];
    const float* w_fox = args.in[9]; const float* w_moba = args.in[10]; const float* w_out = args.in[11];
    h16* Win_t = (h16*)(ws + WS_WIN); h16* Wcat_t = (h16*)(ws + WS_WCAT); h16* Wout_t = (h16*)(ws + WS_WOUT);
    float* rope = (float*)(ws + WS_ROPE); float* logf_ = (float*)(ws + WS_LOGF); float* cum = (float*)(ws + WS_CUM); float* kmean = (float*)(ws + WS_KMEAN); float* gtab = (float*)(ws + WS_GTAB);
    h16* XN = (h16*)(ws + WS_XN); h16* Y = (h16*)(ws + WS_Y); h16* bufs = (h16*)(ws + WS_BUFS); h16* MERGED = (h16*)(ws + WS_MERGED);
    h16* GA = (h16*)(ws + WS_GA); h16* GB = (h16*)(ws + WS_GB); float* irs = (float*)(ws + WS_IRS);
    const int lo = args.ph_lo, hi_ = args.ph_hi;
#define IN(k) (lo <= (k) && (k) < hi_)
#define GRID_BAR(k) do { if (IN(k) && IN((k) + 1)) xcd_barrier<((k) == 0)>(bar); } while (0)

    if (IN(0)) {
        LAS float* scr = (LAS float*)(lds + wave * 16384);
        const int gw = vcu * NWAVES + wave, NGW = G * NWAVES;
        constexpr int I_IN = (DM / 64) * (IN_WG / 32), I_F = (512 / 64) * (DM / 32), I_O = (DM / 64) * (DM / 32);
        constexpr int NITEMS = I_IN + 2 * I_F + I_O;
        for (int it = gw; it < NITEMS; it += NGW) {
            int r = it;
            if (r < I_IN) { p0_transpose_item<true>(w_in, IN_W, Win_t, DM, IN_WG / 32, scr, r, lane); continue; } r -= I_IN;
            if (r < I_F) { p0_transpose_item(w_fox, DM, Wcat_t, DM, DM / 32, scr, r, lane); continue; } r -= I_F;
            if (r < I_F) { p0_transpose_item(w_moba, DM, Wcat_t + 512, DM, DM / 32, scr, r, lane); continue; } r -= I_F;
            p0_transpose_item(w_out, DM, Wout_t, DM, DM / 32, scr, r, lane);
        }
        { const int gid = bx * 512 + tid;
          if (gid < BATCH * NH * 16 * HD) kmean[gid] = 0.f;
          if (gid < 256) { const int wch = gid >> 6; const float* src = args.in[5 + wch]; const float gval = src[gid & 63]; gtab[gid] = gval * (((wch & 1) == 0) ? 8.0f * QSCALE : 8.0f);
              float gm = fabsf(gval);
#pragma unroll
              for (int o = 1; o < 64; o <<= 1) gm = fmaxf(gm, __shfl_xor(gm, o));
              if ((gid & 63) == 0) gtab[256 + wch] = gm; }
          if (gid < SEQ * 8) { const int pos = gid >> 3, i = gid & 7;
              const float invf = (i == 0) ? 1.0f : (i == 1) ? 0.1939227432012558f : (i == 2) ? 0.03760603070259094f : (i == 3) ? 0.007292664609849453f : (i == 4) ? 0.0014142135623842478f
                               : (i == 5) ? 0.00027424818836152554f : (i == 6) ? 5.3182957344688475e-05f : 1.0313385246263351e-05f;
              const float ang = (float)pos * invf; double s, c; sincos_d((double)ang, s, c); rope[gid] = (float)c; rope[SEQ * 8 + gid] = (float)s; } }
        __syncthreads();
        { LAS f32x4* gwl = (LAS f32x4*)lds;
          for (int i = tid; i < DM * 2; i += NWAVES * 64) { const int k = i >> 1, hf = i & 1; gwl[i] = *(const f32x4*)(w_in + (size_t)k * IN_W + IN_WG + 4 * hf) * norm_g[k]; } }
        __syncthreads();
        f32x4 gv[4]; f32x4 gw0[4][4], gw1[4][4];
#pragma unroll
        for (int j = 0; j < 4; ++j) { gv[j] = *(const f32x4*)(norm_g + 256 * j + 4 * lane);
#pragma unroll
            for (int e = 0; e < 4; ++e) { const LAS f32x4* wp = (const LAS f32x4*)lds + (256 * j + 4 * lane + e) * 2; gw0[j][e] = wp[0]; gw1[j][e] = wp[1]; } }
        const int hsel = (lane >> 3) & 7;
        const float bfl = b_f[((lane >> 5) & 1) * 4 + ((lane >> 4) & 1) * 2 + ((lane >> 3) & 1)];
        f32x4 v[4];
        if (gw < M) {
#pragma unroll
            for (int j = 0; j < 4; ++j) v[j] = __builtin_nontemporal_load((const f32x4*)(x + (size_t)gw * DM) + lane + 64 * j); }
        for (int m = gw; m < M; m += NGW) {
            f32x4 nv[4];
            const int mn = (m + NGW < M) ? m + NGW : m;
#pragma unroll
            for (int j = 0; j < 4; ++j) nv[j] = __builtin_nontemporal_load((const f32x4*)(x + (size_t)mn * DM) + lane + 64 * j);
            float ss = 0.f; f32x4 d0 = {0.f, 0.f, 0.f, 0.f}, d1 = {0.f, 0.f, 0.f, 0.f};
#pragma unroll
            for (int j = 0; j < 4; ++j) { ss += (v[j].x * v[j].x + v[j].y * v[j].y) + (v[j].z * v[j].z + v[j].w * v[j].w);
#pragma unroll
                for (int e = 0; e < 4; ++e) { d0 += gw0[j][e] * v[j][e]; d1 += gw1[j][e] * v[j][e]; } }
#define DPPF_(x, ctrl) __int_as_float(__builtin_amdgcn_update_dpp(0, __float_as_int(x), ctrl, 0xF, 0xF, true))
#define SWAPSUM16_(a, b) ([&]{ auto r_ = __builtin_amdgcn_permlane16_swap(__float_as_uint(a), __float_as_uint(b), false, false); return __uint_as_float(r_[0]) + __uint_as_float(r_[1]); }())
#define SWAPSUM32_(a, b) ([&]{ auto r_ = __builtin_amdgcn_permlane32_swap(__float_as_uint(a), __float_as_uint(b), false, false); return __uint_as_float(r_[0]) + __uint_as_float(r_[1]); }())
            ss += DPPF_(ss, 0xB1); ss += DPPF_(ss, 0x4E); ss += DPPF_(ss, 0x141); ss += DPPF_(ss, 0x140); ss = SWAPSUM16_(ss, ss); ss = SWAPSUM32_(ss, ss);
            const float rvar = sqrtf(ss * (1.0f / DM) + RMS_EPS); const float rstd = 1.0f / rvar;
            if (lane == 0) irs[m] = rvar;
            f32x4 a4;
#pragma unroll
            for (int e = 0; e < 4; ++e) a4[e] = SWAPSUM32_(d0[e], d1[e]);
            f32x2 a2; a2[0] = SWAPSUM16_(a4[0], a4[2]); a2[1] = SWAPSUM16_(a4[1], a4[3]);
            float a1; { const bool up = (lane & 8) != 0; const float keep = up ? a2[1] : a2[0], send = up ? a2[0] : a2[1]; a1 = keep + DPPF_(send, 0x128); }
            a1 += DPPF_(a1, 0xB1); a1 += DPPF_(a1, 0x4E); a1 += DPPF_(a1, 0x141);
#undef DPPF_
#undef SWAPSUM16_
#undef SWAPSUM32_
            if ((lane & 7) == 0) { const float z = a1 * rstd + bfl;
                const float lf = fminf(z, 0.f) - 0.6931471805599453f * __builtin_amdgcn_logf(1.0f + __builtin_amdgcn_exp2f(-fabsf(z) * LOG2E));
                const int bb = m >> 12, t = m & 4095; const int hd = ((lane >> 5) & 1) * 4 + ((lane >> 4) & 1) * 2 + ((lane >> 3) & 1); logf_[(size_t)(bb * NH + hd) * SEQ + t] = lf; }
            u32x2 w[4];
#pragma unroll
            for (int j = 0; j < 4; ++j) { const f32x4 hv = v[j] * rstd * gv[j]; w[j].x = pg8::cvt_pk_f16(hv[0], hv[1]); w[j].y = pg8::cvt_pk_f16(hv[2], hv[3]); }
            { const bool odd = (lane & 1) != 0; h16* xrow = XN + (size_t)m * DM + 8 * (lane >> 1);
#pragma unroll
              for (int jp = 0; jp < 2; ++jp) { const u32x2 mine = odd ? w[2 * jp + 1] : w[2 * jp], send = odd ? w[2 * jp] : w[2 * jp + 1];
                  u32x2 recv; recv.x = (unsigned)__builtin_amdgcn_update_dpp(0, (int)send.x, 0xB1, 0xF, 0xF, true); recv.y = (unsigned)__builtin_amdgcn_update_dpp(0, (int)send.y, 0xB1, 0xF, 0xF, true);
                  const u32x4 o = odd ? (u32x4){recv.x, recv.y, mine.x, mine.y} : (u32x4){mine.x, mine.y, recv.x, recv.y};
                  *(u32x4*)(xrow + 256 * (2 * jp + (odd ? 1 : 0))) = o; } }
#pragma unroll
            for (int j = 0; j < 4; ++j) v[j] = nv[j];
        }
        (void)hsel;
        __syncthreads();
    }

    GRID_BAR(0);

    if (IN(1)) {
        pg8::Gemm g{XN, Win_t, M, IN_WG, DM}; pg8::DealtOrder S; S.s.init(M, IN_WG, G, bx);
        pg8::EpiInProj E{bufs, GA, GB, gtab, b_gate, rope, kmean};
        pg8::gemm_phase<pg8::EpiInProj, pg8::DealtOrder, true, true, 0, pg8::CumsumPre>(lds, g, S, E, pg8::CumsumPre{logf_, cum, bx, lds});
    }

    GRID_BAR(1);

    if (IN(2)) {
        const int bh = vcu >> 3, s = vcu & 7, b = bh >> 3, h = bh & 7;
        if (G == 256) {
            const float* cb2h = cum + (size_t)bh * SEQ;
            const float gq = gtab[256], gk = gtab[257], mq = gtab[258], mk = gtab[259];
            const float lmax2f = 8.0f * gq * gk * LOG2E * 1.02f, lmax2m = 8.0f * mq * mk * LOG2E * 1.02f;
            const int qbA = s, qbB = 15 - s; int jsA, jsB;
            const size_t hoff = (size_t)bh * SEQ * HD;
            const h16 *FQ = bufs, *FK = bufs + BUF_ELEMS, *FV = bufs + 2 * BUF_ELEMS, *FZ = bufs + 3 * BUF_ELEMS, *MQ = bufs + 4 * BUF_ELEMS, *MK = bufs + 5 * BUF_ELEMS, *MV = bufs + 6 * BUF_ELEMS, *MZ = bufs + 7 * BUF_ELEMS;
            const float* kmh = kmean + (size_t)bh * 16 * HD;
            if (wave < 4) fa::glds16(kmh + wave * 256 + lane * 4, (unsigned)__builtin_amdgcn_readfirstlane((unsigned)(size_t)lds + fa::LDS_KM + wave * 1024));
            if (wave == 4) fa::glds4(cb2h + 64 * lane + 63, (unsigned)__builtin_amdgcn_readfirstlane((unsigned)(size_t)lds + fa::LDS_END));
            if (wave == 5) fa::glds4(cb2h + 256 * ((lane & 1) ? qbB : qbA) + ((lane & 2) ? 255 : 0), (unsigned)__builtin_amdgcn_readfirstlane((unsigned)(size_t)lds + fa::LDS_END + 256));
            int rot = -1;
            const bool mfix = lmax2m <= 14.0f;
            if (mfix) rot = fa::attn_unit<1, 8, true>(lds, b, h, qbA, MQ, MK, MV, MZ, Y, nullptr, 0.f, 0, kmh, -lmax2m, rot, MK + hoff, MV + hoff, nullptr, 1);
            else      rot = fa::attn_unit<1, 8, false>(lds, b, h, qbA, MQ, MK, MV, MZ, Y, nullptr, 0.f, 0, kmh, -lmax2m, rot, MK + hoff, MV + hoff, nullptr, 1);
            const LAS float* cl = (const LAS float*)(lds + fa::LDS_END);
            { const float ceA = cl[lane], ceB = ceA, cuA = cl[64], cuB = cl[65];
              const unsigned long long bA = __ballot((lane < 4 * qbA + 4) && ((ceA - cuA) + 2.0f * lmax2f >= -32.0f)), bB = __ballot((lane < 4 * qbB + 4) && ((ceB - cuB) + 2.0f * lmax2f >= -32.0f));
              jsA = __builtin_amdgcn_readfirstlane(bA ? (int)__builtin_ctzll(bA) : 0) & ~1; if (jsA > 4 * qbA) jsA = 4 * qbA;
              jsB = __builtin_amdgcn_readfirstlane(bB ? (int)__builtin_ctzll(bB) : 0) & ~1; if (jsB > 4 * qbB) jsB = 4 * qbB; }
            const float crefA = -cl[66], crefB = -cl[67];
            const h16* nFK = FK + hoff + (size_t)jsA * 64 * HD; const h16* nFV = FV + hoff + (size_t)jsA * 64 * HD; const float* nFB = cb2h + jsA * 64 + 64;
            if (mfix) rot = fa::attn_unit<1, 8, true>(lds, b, h, qbB, MQ, MK, MV, MZ, Y, nullptr, 0.f, 0, kmh, -lmax2m, rot, nFK, nFV, nFB, 0);
            else      rot = fa::attn_unit<1, 8, false>(lds, b, h, qbB, MQ, MK, MV, MZ, Y, nullptr, 0.f, 0, kmh, -lmax2m, rot, nFK, nFV, nFB, 0);
            rot = fa::attn_unit<0, 14, false>(lds, b, h, qbA, FQ, FK, FV, FZ, Y, cb2h, crefA, jsA, nullptr, lmax2f, rot,
                                             FK + hoff + (size_t)jsB * 64 * HD, FV + hoff + (size_t)jsB * 64 * HD, cb2h + jsB * 64 + 64, 0);
            (void)fa::attn_unit<0, 14, false>(lds, b, h, qbB, FQ, FK, FV, FZ, Y, cb2h, crefB, jsB, nullptr, lmax2f, rot, nullptr, nullptr, nullptr, -1);
        }
    }

    GRID_BAR(2);

    const bool uni = (MISC[10] == 1u) && (MISC[12] != 0u) && G == 256;
    pg8::OneTile T34;
    if (uni) { const int rk = (int)MISC[12] - 1; T34.pm = 8 * (int)bar.x + (rk & 7); T34.pn = rk >> 3; }
    else { pg8::StaticOrder S; S.init(M, DM, G, bx); pg8::Unit u0; u0.pm = 0; u0.pn = 0; (void)S.next(0, u0); T34.pm = u0.pm; T34.pn = u0.pn; }

    if (IN(3)) {
        pg8::Gemm g{Y, Wcat_t, M, DM, DM};
        pg8::EpiMerge E{(const unsigned char*)GA, (const unsigned char*)GB, MERGED};
        pg8::gemm_phase<pg8::EpiMerge, pg8::OneTile, false>(lds, g, T34, E);
    }

    if (IN(3) && IN(4)) {
        if (uni) {
            asm volatile("s_waitcnt vmcnt(0)" ::: "memory");
            __syncthreads();
            if (threadIdx.x == 0) { unsigned* fl = bar.bar + 4096 + 32 * T34.pm;
                xb_add(fl, 1u); }
        } else xcd_barrier<false>(bar);
    }

    if (IN(4)) {
        pg8::Gemm g{MERGED, Wout_t, M, DM, DM};
        pg8::EpiOut E{x, args.out, XN, irs, norm_g};
        pg8::gemm_phase<pg8::EpiOut, pg8::OneTile, false, false, 16, pg8::NoPre, SeamWait>(lds, g, T34, E, pg8::NoPre(), SeamWait{bar.bar + 4096 + 32 * T34.pm, bar.bar, uni && IN(3) && IN(4)});
    }
#undef IN
#undef GRID_BAR
}

extern "C" void kernel_launch(void* const* d_in, const int* in_sizes, int n_in, void* d_out, int out_size, void* d_ws, size_t ws_size, hipStream_t stream) {
    static int grid = 0;
    if (grid == 0) {
        if (n_in != 12 || in_sizes[0] != M * DM || out_size != M * DM || ws_size < WS_END) { fprintf(stderr, "kernel_launch: unexpected shapes (n_in %d, in0 %d, out %d, ws %zu)\n", n_in, n_in > 0 ? in_sizes[0] : -1, out_size, ws_size); grid = -1; return; }
        if (hipFuncSetAttribute((const void*)fwd, hipFuncAttributeMaxDynamicSharedMemorySize, LDS_BYTES) != hipSuccess) { fprintf(stderr, "kernel_launch: hipFuncSetAttribute failed\n"); grid = -1; return; }
        int dev = 0, cus = 0, per_cu = 0; (void)hipGetDevice(&dev); (void)hipDeviceGetAttribute(&cus, hipDeviceAttributeMultiprocessorCount, dev);
        if (hipOccupancyMaxActiveBlocksPerMultiprocessor(&per_cu, (const void*)fwd, NWAVES * 64, LDS_BYTES) != hipSuccess || per_cu < 1) { fprintf(stderr, "kernel_launch: occupancy query says %d blocks per CU\n", per_cu); grid = -1; return; }
        grid = cus;
        if (grid != 256) fprintf(stderr, "kernel_launch: %d CUs (built for 256)\n", grid);
    }
    if (grid < 0) return;
    Args a{};
    for (int i = 0; i < 12; ++i) a.in[i] = (const float*)d_in[i];
    a.out = (float*)d_out; a.ws = (unsigned char*)d_ws; a.ph_lo = 0; a.ph_hi = 5;
    if (hipMemsetAsync((char*)d_ws + WS_CTL, 0, CTL_ZERO_BYTES, stream) != hipSuccess) { fprintf(stderr, "kernel_launch: hipMemsetAsync failed\n"); return; }
    hipLaunchKernelGGL(fwd, dim3(grid), dim3(NWAVES * 64), LDS_BYTES, stream, a);
    const hipError_t e = hipPeekAtLastError();
    if (e != hipSuccess) fprintf(stderr, "kernel_launch: launch failed: %s (grid %d)\n", hipGetErrorString(e), grid);
}
```
